# Optimizing an MI355X kernel written in HIP

```python
import math
import jax, jax.numpy as jnp
from jax import lax
import numpy as np

D_MODEL = 2048
BATCH = 4
SEQ = 2048
DEPTH = 2

N_MIXERS = 2
PLE_DIM = 256
D_FF = ((8 * D_MODEL // 3 + 255) // 256) * 256
EPS = 1e-6

GM_WIDTH = D_MODEL
GM_CHUNK = 128
GM_HEAD_DIM = 128
GM_HEADS = GM_WIDTH // GM_HEAD_DIM

S5_WIDTH = D_MODEL
S5_GROUP = 16
S5_GROUPS = S5_WIDTH // S5_GROUP
S5_STATE = 64
DT_MIN = 1e-3
DT_MAX = 1e-1

N_A = (DEPTH + 1) // 2
N_B = DEPTH // 2

kernel_name = "hybrid_gmlp_s5_interleaved_trunk"


def _rms_norm(x, g):
    xf = x.astype(jnp.float32)
    y = xf * lax.rsqrt(jnp.mean(xf * xf, axis=-1, keepdims=True) + EPS)
    return (y * g.astype(jnp.float32)).astype(x.dtype)


def _layer_norm(x, g, b):
    xf = x.astype(jnp.float32)
    mu = jnp.mean(xf, axis=-1, keepdims=True)
    xc = xf - mu
    y = xc * lax.rsqrt(jnp.mean(xc * xc, axis=-1, keepdims=True) + EPS)
    return (y * g.astype(jnp.float32) + b.astype(jnp.float32)).astype(x.dtype)


def _gmlp_mixer(h, w_in, ln_g, ln_b, w_s, b_s, w_out):
    bsz, seq, _ = h.shape
    z = jax.nn.gelu(h @ w_in)
    u, v = jnp.split(z, 2, axis=-1)
    v = _layer_norm(v, ln_g, ln_b)
    vc = v.reshape(bsz, seq // GM_CHUNK, GM_CHUNK, GM_HEADS, GM_HEAD_DIM)
    causal = jnp.tril(jnp.ones((GM_CHUNK, GM_CHUNK), dtype=bool))
    w_causal = jnp.where(causal, w_s, jnp.zeros_like(w_s)).astype(v.dtype)
    sv = jnp.einsum('hts,bnshd->bnthd', w_causal, vc) + b_s.T[:, :, None].astype(v.dtype)
    return (u * sv.reshape(bsz, seq, GM_WIDTH)) @ w_out


def _lin_combine(left, right):
    a_l, b_l = left
    a_r, b_r = right
    return a_r * a_l, a_r * b_l + b_r


def _s5_mixer(h, w_in, a_re, a_im, log_dt, b_re, b_im, c_re, c_im, d, w_out):
    f32 = jnp.float32
    bsz, seq, _ = h.shape
    u = (h @ w_in).astype(f32)
    lam = lax.complex(a_re.astype(f32), a_im.astype(f32))
    dt = jnp.exp(log_dt.astype(f32))[:, None]
    lam_bar = jnp.exp(lam * dt)
    b_bar = ((lam_bar - 1.0) / lam)[..., None] * lax.complex(b_re.astype(f32), b_im.astype(f32))
    ug = u.reshape(bsz, seq, S5_GROUPS, S5_GROUP)
    bu = lax.complex(jnp.einsum('blgc,gpc->blgp', ug, jnp.real(b_bar)),
                     jnp.einsum('blgc,gpc->blgp', ug, jnp.imag(b_bar)))
    a = jnp.broadcast_to(lam_bar, (1, seq) + lam_bar.shape)
    _, s = lax.associative_scan(_lin_combine, (a, bu), axis=1)
    y = (jnp.einsum('blgp,gcp->blgc', jnp.real(s), c_re.astype(f32))
         - jnp.einsum('blgp,gcp->blgc', jnp.imag(s), c_im.astype(f32)))
    y = y.reshape(bsz, seq, S5_WIDTH) + d.astype(f32) * u
    g = jax.nn.gelu(y).astype(h.dtype)
    val, gate = jnp.split(g @ w_out, 2, axis=-1)
    return val * jax.nn.sigmoid(gate)


def _swiglu(h, w1, w3, w2):
    return (jax.nn.silu(h @ w1) * (h @ w3)) @ w2


def _normal(k, shape, scale):
    return jax.random.normal(k, shape, jnp.float32) * scale


def setup_inputs(seed: int = 0) -> dict:
    key = jax.random.key(seed)
    ks = jax.random.split(key, 32)
    D = D_MODEL
    x = _normal(ks[0], (BATCH, SEQ, D), 1.0)
    p = _normal(ks[1], (DEPTH, BATCH, SEQ, PLE_DIM), 1.0)
    norm_mix = 1.0 + _normal(ks[2], (DEPTH, D), 0.02)
    norm_ffn = 1.0 + _normal(ks[3], (DEPTH, D), 0.02)
    norm_ple = 1.0 + _normal(ks[4], (DEPTH, D), 0.02)
    norm_final = 1.0 + _normal(ks[5], (D,), 0.02)
    gm_w_in = _normal(ks[6], (N_A, D, 2 * GM_WIDTH), D ** -0.5)
    gm_ln_g = 1.0 + _normal(ks[7], (N_A, GM_WIDTH), 0.02)
    gm_ln_b = _normal(ks[8], (N_A, GM_WIDTH), 0.02)
    gm_w_s = _normal(ks[9], (N_A, GM_HEADS, GM_CHUNK, GM_CHUNK), GM_CHUNK ** -0.5)
    gm_b_s = 1.0 + _normal(ks[10], (N_A, GM_HEADS, GM_CHUNK), 0.02)
    gm_w_out = _normal(ks[11], (N_A, GM_WIDTH, D), GM_WIDTH ** -0.5)
    s5_w_in = _normal(ks[12], (N_B, D, S5_WIDTH), D ** -0.5)
    s5_a_re = -0.5 + _normal(ks[13], (N_B, S5_GROUPS, S5_STATE), 0.01)
    n_idx = jnp.arange(S5_STATE, dtype=jnp.float32)
    s5_a_im = math.pi * n_idx + _normal(ks[14], (N_B, S5_GROUPS, S5_STATE), 0.01)
    s5_log_dt = jax.random.uniform(ks[15], (N_B, S5_GROUPS), jnp.float32,
                                   math.log(DT_MIN), math.log(DT_MAX))
    b_scale = (S5_GROUP ** -0.5) / math.sqrt(2.0)
    s5_b_re = _normal(ks[16], (N_B, S5_GROUPS, S5_STATE, S5_GROUP), b_scale)
    s5_b_im = _normal(ks[17], (N_B, S5_GROUPS, S5_STATE, S5_GROUP), b_scale)
    c_scale = (S5_STATE ** -0.5) / math.sqrt(2.0)
    s5_c_re = _normal(ks[18], (N_B, S5_GROUPS, S5_GROUP, S5_STATE), c_scale)
    s5_c_im = _normal(ks[19], (N_B, S5_GROUPS, S5_GROUP, S5_STATE), c_scale)
    s5_d = _normal(ks[20], (N_B, S5_WIDTH), 1.0)
    s5_w_out = _normal(ks[21], (N_B, S5_WIDTH, 2 * D), S5_WIDTH ** -0.5)
    ffn_w1 = _normal(ks[22], (DEPTH, D, D_FF), D ** -0.5)
    ffn_w3 = _normal(ks[23], (DEPTH, D, D_FF), D ** -0.5)
    ffn_w2 = _normal(ks[24], (DEPTH, D_FF, D), D_FF ** -0.5)
    ple_w_gate = _normal(ks[25], (DEPTH, D, D), D ** -0.5)
    ple_w_proj = _normal(ks[26], (DEPTH, PLE_DIM, D), PLE_DIM ** -0.5)
    return {
        "x": x, "p": p,
        "norm_mix": norm_mix, "norm_ffn": norm_ffn, "norm_ple": norm_ple, "norm_final": norm_final,
        "gm_w_in": gm_w_in, "gm_ln_g": gm_ln_g, "gm_ln_b": gm_ln_b,
        "gm_w_s": gm_w_s, "gm_b_s": gm_b_s, "gm_w_out": gm_w_out,
        "s5_w_in": s5_w_in, "s5_a_re": s5_a_re, "s5_a_im": s5_a_im, "s5_log_dt": s5_log_dt,
        "s5_b_re": s5_b_re, "s5_b_im": s5_b_im, "s5_c_re": s5_c_re, "s5_c_im": s5_c_im,
        "s5_d": s5_d, "s5_w_out": s5_w_out,
        "ffn_w1": ffn_w1, "ffn_w3": ffn_w3, "ffn_w2": ffn_w2,
        "ple_w_gate": ple_w_gate, "ple_w_proj": ple_w_proj,
    }


def reference(x, p, norm_mix, norm_ffn, norm_ple, norm_final,
              gm_w_in, gm_ln_g, gm_ln_b, gm_w_s, gm_b_s, gm_w_out,
              s5_w_in, s5_a_re, s5_a_im, s5_log_dt, s5_b_re, s5_b_im, s5_c_re, s5_c_im,
              s5_d, s5_w_out,
              ffn_w1, ffn_w3, ffn_w2, ple_w_gate, ple_w_proj):
    for i in range(DEPTH):
        j = i // N_MIXERS
        h = _rms_norm(x, norm_mix[i])
        if i % N_MIXERS == 0:
            x = x + _gmlp_mixer(h, gm_w_in[j], gm_ln_g[j], gm_ln_b[j], gm_w_s[j], gm_b_s[j], gm_w_out[j])
        else:
            x = x + _s5_mixer(h, s5_w_in[j], s5_a_re[j], s5_a_im[j], s5_log_dt[j],
                              s5_b_re[j], s5_b_im[j], s5_c_re[j], s5_c_im[j], s5_d[j], s5_w_out[j])
        x = x + _swiglu(_rms_norm(x, norm_ffn[i]), ffn_w1[i], ffn_w3[i], ffn_w2[i])
        gate = jax.nn.sigmoid(_rms_norm(x, norm_ple[i]) @ ple_w_gate[i])
        x = x + gate * (p[i] @ ple_w_proj[i])
    return _rms_norm(x, norm_final)
```

```cpp
#include <hip/hip_runtime.h>
#include <hip/hip_cooperative_groups.h>
#include <cstdio>
#include <cstdint>
namespace cg = cooperative_groups;
#define CONV_IN_SCAN 1
#define LATE_SET 50
#define CONV_PLAIN 1
#define CONV_KA 0
#define SEG_B 8
#define P3_BF16_RES 1
namespace pg8 {
#define PG8_LAS __attribute__((address_space(3)))
typedef unsigned short bf16_t;
typedef short bf16x8 __attribute__((ext_vector_type(8)));
typedef float f32x4 __attribute__((ext_vector_type(4)));
typedef unsigned u32x4 __attribute__((ext_vector_type(4)));
constexpr int BM = 256, BK = 64, HALF = 128, HTB = HALF * BK * 2  , STAGE_BYTES = 8 * HTB, NXCD = 8, WGM = 8;

__host__ __device__ __forceinline__ int lds_byte(int r, int c) { const int st = (r >> 4) * 2 + (c >> 5), rr = r & 15, cc = c & 31, ob = rr * 64 + cc * 2; return st * 1024 + (ob ^ (((ob >> 9) & 1) << 5)); }
__host__ __device__ __forceinline__ void stage_rc(int b, int& R, int& C) { const int st = b / 1024, sb = b % 1024, swz = sb ^ (((sb >> 9) & 1) << 5); R = (st >> 1) * 16 + swz / 64; C = (st & 1) * 32 + (swz % 64) / 2; }
__host__ __device__ __forceinline__ int perm32(int rho) { const int n = rho >> 4, i = rho & 15; return 8 * (i >> 2) + 4 * n + (i & 3); }

struct Unit { int pm, pn, half; };
struct Gemm { const bf16_t* A; const bf16_t* Bt; int M, N, K; };

struct StaticOrder {
    int nM, nN, nwg, G, c;
    __host__ __device__ void init(int M, int N, int G_, int c_) { nM = M / BM; nN = N / BM; nwg = nM * nN; G = G_; c = c_; }
    __host__ __device__ bool next(int i, Unit& u) const {
        const long L = (long)i * G + c; if (L >= nwg) return false;
        int wgid = (int)L; { const int q = nwg / NXCD, r = nwg % NXCD, xcd = wgid % NXCD, off = wgid / NXCD; wgid = (xcd < r ? xcd * (q + 1) : r * (q + 1) + (xcd - r) * q) + off; }
        const int nig = WGM * nN, gid = wgid / nig, fm = gid * WGM, gsz = (nM - fm) < WGM ? (nM - fm) : WGM;
        u.pm = fm + ((wgid % nig) % gsz); u.pn = (wgid % nig) / gsz; u.half = 0; return true;
    }
    __device__ __forceinline__ void a_ready(const Unit&) const {}
    __device__ __forceinline__ void done(const Unit&) const {}
};

struct HalfTailOrder : StaticOrder {
    int full_rounds;
    __host__ __device__ bool next(int i, Unit& u) const {
        if (i < full_rounds) { StaticOrder t = *this; return t.StaticOrder::next(i, u); }
        if (i > full_rounds) return false;
        StaticOrder t = *this; t.c = (c >> 1); t.G = 0; const long L = (long)full_rounds * G + (c >> 1); if (L >= nwg) return false;
        t.c = (int)L; const bool ok = t.StaticOrder::next(0, u); u.half = 1 + (c & 1); return ok;
    }
};

__device__ __forceinline__ unsigned cvt_pk_bf16(float lo, float hi) { unsigned r; asm volatile("v_cvt_pk_bf16_f32 %0, %1, %2" : "=v"(r) : "v"(lo), "v"(hi)); return r; }
typedef unsigned u32x2 __attribute__((ext_vector_type(2)));
__device__ __forceinline__ int lane_id_now() { int l; asm volatile("v_mbcnt_lo_u32_b32 %0, -1, 0\n\tv_mbcnt_hi_u32_b32 %0, -1, %0" : "=v"(l)); return l; }
constexpr int DM = 2048;
constexpr float RMS_EPS = 1e-6f;
__device__ __forceinline__ float fast_sigmoid(float x) { return __builtin_amdgcn_rcpf(1.0f + __builtin_amdgcn_exp2f(-1.4426950409f * x)); }
__device__ __forceinline__ float gelu_tanh(float x) { const float u = x * (0.7978845608f + 0.0356774081f * x * x); return x * fast_sigmoid(2.0f * u); }
__device__ __forceinline__ float bf_lo(unsigned w) { return __uint_as_float(w << 16); }
__device__ __forceinline__ float bf_hi(unsigned w) { return __uint_as_float(w & 0xffff0000u); }
template <int NPART> __device__ __forceinline__ float row_rstd(const float* part, int row, int fq) {
    const f32x4* pp = (const f32x4*)(part + (size_t)row * NPART) + fq * (NPART / 16);
    float s = 0.f;
#pragma unroll
    for (int j = 0; j < NPART / 16; ++j) { const f32x4 v = pp[j]; s += (v[0] + v[1]) + (v[2] + v[3]); }
    s += __shfl_xor(s, 16); s += __shfl_xor(s, 32);
    return rsqrtf(s * (1.0f / DM) + RMS_EPS);
}

template <int ACT  , bool RSTD, bool VSTATS, int NPART> struct EpiBf16G {
    static constexpr bool PERM = true, AFTER_DRAIN = false;
    bf16_t* O; int ldc; const float* part; float* vstat; int vs_pn0;
    __device__ __forceinline__ void operator()(const f32x4 (&acc)[2][2][4][2], const Unit& u, int wr, int wc, int fr, int fq) const {
        const int row0 = u.pm * BM + wr * 64 + fr, col0 = u.pn * BM + wc * 32 + 8 * fq;
        const bool dov = VSTATS && (u.pn >= vs_pn0);
#pragma unroll
        for (int ai = 0; ai < 2; ++ai)
#pragma unroll
            for (int m = 0; m < 4; ++m) { const int row = row0 + ai * HALF + m * 16;
                float rs = 1.0f; if (RSTD) rs = row_rstd<NPART>(part, row, fq);
                bf16_t* rowp = O + (size_t)row * ldc + col0; float s1 = 0.f, s2 = 0.f;
#pragma unroll
                for (int bj = 0; bj < 2; ++bj) { f32x4 v0 = acc[ai][bj][m][0] * rs, v1 = acc[ai][bj][m][1] * rs;
                    if (ACT == 1) {
#pragma unroll
                        for (int j = 0; j < 4; ++j) { v0[j] = gelu_tanh(v0[j]); v1[j] = gelu_tanh(v1[j]); } }
                    if (VSTATS) {
#pragma unroll
                        for (int j = 0; j < 4; ++j) { s1 += v0[j] + v1[j]; s2 += v0[j] * v0[j] + v1[j] * v1[j]; } }
                    u32x4 w; w.x = cvt_pk_bf16(v0[0], v0[1]); w.y = cvt_pk_bf16(v0[2], v0[3]); w.z = cvt_pk_bf16(v1[0], v1[1]); w.w = cvt_pk_bf16(v1[2], v1[3]);
                    *(u32x4*)(rowp + bj * HALF) = w; }
                if (VSTATS) { s1 += __shfl_xor(s1, 16); s1 += __shfl_xor(s1, 32); s2 += __shfl_xor(s2, 16); s2 += __shfl_xor(s2, 32);
                    if (dov && fq == 0) { float* vp = vstat + ((size_t)row * 32 + (u.pn - vs_pn0) * 4 + wc) * 2; vp[0] = s1; vp[1] = s2; } }
                asm volatile("" ::: "memory");
            }
    }
};

template <int MODE, int NPART, bool XIN_F32, bool XOUT_F32> struct EpiRes {
    static constexpr bool PERM = true, AFTER_DRAIN = false;
    const float* xin_f; const bf16_t* xin_b; float* xout_f; bf16_t* xout_b; float* part_out; const float* part_in; const bf16_t* proj;
    __device__ __forceinline__ void operator()(const f32x4 (&acc)[2][2][4][2], const Unit& u, int wr, int wc, int fr, int fq) const {
        const int row0 = u.pm * BM + wr * 64 + fr, col0 = u.pn * BM + wc * 32 + 8 * fq;
#pragma unroll
        for (int ai = 0; ai < 2; ++ai)
#pragma unroll
            for (int m = 0; m < 4; ++m) { const int row = row0 + ai * HALF + m * 16;
                float rs = 1.0f; if (MODE == 1) rs = row_rstd<NPART>(part_in, row, fq);
                const size_t off = (size_t)row * DM + col0; float ss = 0.f;
#pragma unroll
                for (int bj = 0; bj < 2; ++bj) { const size_t o = off + bj * HALF;
                    f32x4 x0, x1;
                    if (XIN_F32) { x0 = *(const f32x4*)(xin_f + o); x1 = *(const f32x4*)(xin_f + o + 4); }
                    else { const u32x4 w = *(const u32x4*)(xin_b + o); x0 = (f32x4){bf_lo(w.x), bf_hi(w.x), bf_lo(w.y), bf_hi(w.y)}; x1 = (f32x4){bf_lo(w.z), bf_hi(w.z), bf_lo(w.w), bf_hi(w.w)}; }
                    f32x4 a0 = acc[ai][bj][m][0], a1 = acc[ai][bj][m][1];
                    if (MODE == 1) { const u32x4 p = *(const u32x4*)(proj + o);
                        a0[0] = fast_sigmoid(a0[0] * rs) * bf_lo(p.x); a0[1] = fast_sigmoid(a0[1] * rs) * bf_hi(p.x); a0[2] = fast_sigmoid(a0[2] * rs) * bf_lo(p.y); a0[3] = fast_sigmoid(a0[3] * rs) * bf_hi(p.y);
                        a1[0] = fast_sigmoid(a1[0] * rs) * bf_lo(p.z); a1[1] = fast_sigmoid(a1[1] * rs) * bf_hi(p.z); a1[2] = fast_sigmoid(a1[2] * rs) * bf_lo(p.w); a1[3] = fast_sigmoid(a1[3] * rs) * bf_hi(p.w); }
                    const f32x4 n0 = x0 + a0, n1 = x1 + a1;
                    if (XOUT_F32) { *(f32x4*)(xout_f + o) = n0; *(f32x4*)(xout_f + o + 4) = n1; }
                    else { u32x4 w; w.x = cvt_pk_bf16(n0[0], n0[1]); w.y = cvt_pk_bf16(n0[2], n0[3]); w.z = cvt_pk_bf16(n1[0], n1[1]); w.w = cvt_pk_bf16(n1[2], n1[3]); *(u32x4*)(xout_b + o) = w; }
                    ss += ((n0[0] * n0[0] + n0[1] * n0[1]) + (n0[2] * n0[2] + n0[3] * n0[3])) + ((n1[0] * n1[0] + n1[1] * n1[1]) + (n1[2] * n1[2] + n1[3] * n1[3])); }
                ss += __shfl_xor(ss, 16); ss += __shfl_xor(ss, 32);
                if (!XOUT_F32 && fq == 0) part_out[(size_t)row * 32 + u.pn * 4 + wc] = ss;
                asm volatile("" ::: "memory"); }
    }
};

template <int NPART> struct EpiSwiGLU {
    static constexpr bool PERM = true, AFTER_DRAIN = false;
    bf16_t* O; int ldc; const float* part;
    __device__ __forceinline__ void operator()(const f32x4 (&acc)[2][2][4][2], const Unit& u, int wr, int wc, int fr, int fq) const {
        const int row0 = u.pm * BM + (u.half == 2 ? HALF : 0) + wr * 64 + fr, col0 = u.pn * HALF + wc * 32 + 8 * fq;
#pragma unroll
        for (int ai = 0; ai < 2; ++ai) { if (ai == 1 && u.half != 0) break;
#pragma unroll
            for (int m = 0; m < 4; ++m) { const int row = row0 + ai * HALF + m * 16;
                const float rs = row_rstd<NPART>(part, row, fq);
                float h[8];
#pragma unroll
                for (int n = 0; n < 2; ++n)
#pragma unroll
                    for (int j = 0; j < 4; ++j) { const float a1 = acc[ai][0][m][n][j] * rs, a3 = acc[ai][1][m][n][j] * rs; h[n * 4 + j] = a1 * fast_sigmoid(a1) * a3; }
                u32x4 w; w.x = cvt_pk_bf16(h[0], h[1]); w.y = cvt_pk_bf16(h[2], h[3]); w.z = cvt_pk_bf16(h[4], h[5]); w.w = cvt_pk_bf16(h[6], h[7]);
                *(u32x4*)(O + (size_t)row * ldc + col0) = w; asm volatile("" ::: "memory"); } }
    }
};

struct EpiGLURes {
    static constexpr bool PERM = true, AFTER_DRAIN = false;
    const bf16_t* xin_b; bf16_t* xout_b; float* part_out;
    __device__ __forceinline__ void operator()(const f32x4 (&acc)[2][2][4][2], const Unit& u, int wr, int wc, int fr, int fq) const {
        const int row0 = u.pm * BM + wr * 64 + fr, col0 = u.pn * HALF + wc * 32 + 8 * fq;
#pragma unroll
        for (int ai = 0; ai < 2; ++ai)
#pragma unroll
            for (int m = 0; m < 4; ++m) { const int row = row0 + ai * HALF + m * 16;
                const size_t o = (size_t)row * DM + col0; float ss = 0.f;
                const u32x4 xw = *(const u32x4*)(xin_b + o); const float xo[8] = {bf_lo(xw.x), bf_hi(xw.x), bf_lo(xw.y), bf_hi(xw.y), bf_lo(xw.z), bf_hi(xw.z), bf_lo(xw.w), bf_hi(xw.w)};
                float xn[8];
#pragma unroll
                for (int n = 0; n < 2; ++n)
#pragma unroll
                    for (int j = 0; j < 4; ++j) { xn[n * 4 + j] = xo[n * 4 + j] + acc[ai][0][m][n][j] * fast_sigmoid(acc[ai][1][m][n][j]); ss += xn[n * 4 + j] * xn[n * 4 + j]; }
                u32x4 w; w.x = cvt_pk_bf16(xn[0], xn[1]); w.y = cvt_pk_bf16(xn[2], xn[3]); w.z = cvt_pk_bf16(xn[4], xn[5]); w.w = cvt_pk_bf16(xn[6], xn[7]); *(u32x4*)(xout_b + o) = w;
                ss += __shfl_xor(ss, 16); ss += __shfl_xor(ss, 32);
                if (fq == 0) part_out[(size_t)row * 64 + u.pn * 4 + wc] = ss;
                asm volatile("" ::: "memory"); }
    }
};

template <class Epi, class Sched, bool ALIGN_EPI = false, bool SP2 = false, bool HALFM = false>
__device__ __forceinline__ void gemm_phase(PG8_LAS unsigned char* lds, const Gemm g, const Sched& S, const Epi& E, const int wave_sgpr) {
    int tid_ = wave_sgpr * 64 + lane_id_now(); asm volatile("" : "+v"(tid_));
    const int tid = tid_, wid = __builtin_amdgcn_readfirstlane(tid >> 6), lane = tid & 63, wr = wid >> 2, wc = wid & 3, fr = lane & 15, fq = lane >> 4;
    const int K = g.K, nt = K / BK;
    unsigned voffA[2], voffB[2];
#pragma unroll
    for (int i = 0; i < 2; ++i) { int R, C; stage_rc(tid * 16 + i * 8192, R, C); const int Rb = Epi::PERM ? ((R & ~31) + perm32(R & 31)) : R;
        voffA[i] = (unsigned)(R * K + C) * 2u; voffB[i] = (unsigned)(Rb * K + C) * 2u; }
    const size_t kstep = (size_t)(BK * 2);
    const size_t hstep = (size_t)HALF * K * 2;
    const size_t tstep = 2 * hstep;
    const unsigned ldsw = (unsigned)wid * 1024u;
    const int aoff = lds_byte(wr * 64 + fr, fq * 8), boff = lds_byte(wc * 32 + fr, fq * 8);
#define PG8_SA(b, h) (((b) * 2 + (h)) * HTB)
#define PG8_SB(b, h) ((4 + (b) * 2 + (h)) * HTB)
#define PG8_STAGE(bufoff, gbase, voff) do { _Pragma("unroll") for (int _i = 0; _i < 2; ++_i) \
        __builtin_amdgcn_global_load_lds((const unsigned*)((const char*)(gbase) + (voff)[_i]), (PG8_LAS unsigned*)(lds + (bufoff) + ldsw + _i * 8192), 16, 0, 0); } while (0)
#define PG8_LDA(dst, b, h) do { _Pragma("unroll") for (int m = 0; m < 4; ++m) _Pragma("unroll") for (int k = 0; k < 2; ++k) dst[m][k] = *(const PG8_LAS bf16x8*)(lds + PG8_SA(b, h) + aoff + m * 2048 + k * 1024); } while (0)
#define PG8_LDB(dst, b, h) do { _Pragma("unroll") for (int n = 0; n < 2; ++n) _Pragma("unroll") for (int k = 0; k < 2; ++k) dst[n][k] = *(const PG8_LAS bf16x8*)(lds + PG8_SB(b, h) + boff + n * 2048 + k * 1024); } while (0)
#define PG8_MMA(ai, bj, At, Bt) do { __builtin_amdgcn_s_setprio(1); _Pragma("unroll") for (int m = 0; m < 4; ++m) _Pragma("unroll") for (int n = 0; n < 2; ++n) _Pragma("unroll") for (int k = 0; k < 2; ++k) \
        acc[ai][bj][m][n] = __builtin_amdgcn_mfma_f32_16x16x32_bf16(Bt[n][k], At[m][k], acc[ai][bj][m][n], 0, 0, 0); __builtin_amdgcn_s_setprio(0); } while (0)
#define PG8_WAIT_V(n) asm volatile("s_waitcnt vmcnt(" #n ")" ::: "memory")
#define PG8_WAIT_L(n) asm volatile("s_waitcnt lgkmcnt(" #n ")" ::: "memory")
#define PG8_BAR __builtin_amdgcn_s_barrier()
#define PG8_SCHED __builtin_amdgcn_sched_barrier(0)
    Unit cur, nxt; int ui = 0;
    if (!S.next(0, cur)) return;
    f32x4 acc[2][2][4][2];
#pragma unroll
    for (int a = 0; a < 2; ++a)
#pragma unroll
        for (int b = 0; b < 2; ++b)
#pragma unroll
            for (int m = 0; m < 4; ++m)
#pragma unroll
                for (int n = 0; n < 2; ++n) acc[a][b][m][n] = (f32x4){0.f, 0.f, 0.f, 0.f};
    bf16x8 At[4][2], B0[2][2], B1[2][2];
    const char* cA = (const char*)g.A + (size_t)cur.pm * tstep + ((HALFM && cur.half == 2) ? hstep : 0); const char* cB = (const char*)g.Bt + (size_t)cur.pn * tstep;
    S.a_ready(cur);
    if constexpr (SP2) {
        PG8_STAGE(PG8_SB(0, 0), cB, voffB); PG8_STAGE(PG8_SB(0, 1), cB + hstep, voffB); PG8_STAGE(PG8_SA(0, 0), cA, voffA); PG8_STAGE(PG8_SA(0, 1), cA + hstep, voffA);
        if (wr == 1) PG8_BAR;
        PG8_WAIT_V(2); PG8_BAR;
        PG8_STAGE(PG8_SB(1, 0), cB + kstep, voffB); PG8_STAGE(PG8_SA(1, 0), cA + kstep, voffA); PG8_STAGE(PG8_SB(1, 1), cB + hstep + kstep, voffB);
        PG8_WAIT_V(6); PG8_BAR;
    } else {
        PG8_STAGE(PG8_SB(0, 0), cB, voffB); PG8_STAGE(PG8_SA(0, 0), cA, voffA); PG8_STAGE(PG8_SB(0, 1), cB + hstep, voffB); PG8_STAGE(PG8_SA(0, 1), cA + hstep, voffA);
        if (wr == 1) PG8_BAR;
        PG8_WAIT_V(4); PG8_BAR;
        PG8_STAGE(PG8_SB(1, 0), cB + kstep, voffB); PG8_STAGE(PG8_SA(1, 0), cA + kstep, voffA); PG8_STAGE(PG8_SB(1, 1), cB + hstep + kstep, voffB);
        PG8_WAIT_V(6); PG8_BAR;
    }
    for (;;) {
        const bool has_next = S.next(ui + 1, nxt);
        const char* nA = has_next ? (const char*)g.A + (size_t)nxt.pm * tstep + ((HALFM && nxt.half == 2) ? hstep : 0) : cA; const char* nB = has_next ? (const char*)g.Bt + (size_t)nxt.pn * tstep : cB;
        for (int t = 0; t < nt; t += 2) {
            const bool last = (t == nt - 2);
            const char* a1 = cA + (size_t)(t + 1) * kstep;
            const char* a2 = last ? nA : cA + (size_t)(t + 2) * kstep; const char* b2 = last ? nB : cB + (size_t)(t + 2) * kstep;
            const char* a3 = a2 + kstep; const char* b3 = b2 + kstep;
            if (last && has_next) S.a_ready(nxt);
            if constexpr (SP2) {
            PG8_LDB(B0, 0, 0); PG8_LDB(B1, 0, 1); PG8_SCHED; PG8_LDA(At, 0, 0); PG8_STAGE(PG8_SA(1, 1), a1 + hstep, voffA);
            PG8_WAIT_V(8); PG8_WAIT_L(0); PG8_BAR; PG8_MMA(0, 0, At, B0); PG8_MMA(0, 1, At, B1); PG8_BAR; PG8_SCHED;
            PG8_LDA(At, 0, 1); PG8_STAGE(PG8_SB(0, 0), b2, voffB); PG8_STAGE(PG8_SB(0, 1), b2 + hstep, voffB); PG8_STAGE(PG8_SA(0, 0), a2, voffA);
            PG8_WAIT_V(8); PG8_WAIT_L(0); PG8_BAR; if (!HALFM || cur.half == 0) { PG8_MMA(1, 0, At, B0); PG8_MMA(1, 1, At, B1); } PG8_BAR; PG8_SCHED;
            PG8_LDB(B0, 1, 0); PG8_LDB(B1, 1, 1); PG8_SCHED; PG8_LDA(At, 1, 0); PG8_STAGE(PG8_SA(0, 1), a2 + hstep, voffA);
            PG8_WAIT_V(8); PG8_WAIT_L(0); PG8_BAR; PG8_MMA(0, 0, At, B0); PG8_MMA(0, 1, At, B1); PG8_BAR; PG8_SCHED;
            PG8_LDA(At, 1, 1); PG8_STAGE(PG8_SB(1, 0), b3, voffB); PG8_STAGE(PG8_SB(1, 1), b3 + hstep, voffB); PG8_STAGE(PG8_SA(1, 0), a3, voffA);
            PG8_WAIT_V(8); PG8_WAIT_L(0); PG8_BAR; if (!HALFM || cur.half == 0) { PG8_MMA(1, 0, At, B0); PG8_MMA(1, 1, At, B1); } PG8_BAR; PG8_SCHED;
            } else {
            PG8_LDB(B0, 0, 0); PG8_SCHED; PG8_LDA(At, 0, 0); PG8_STAGE(PG8_SA(1, 1), a1 + hstep, voffA);
            PG8_WAIT_L(8); PG8_BAR; PG8_WAIT_L(0); PG8_MMA(0, 0, At, B0); PG8_BAR; PG8_SCHED;
            PG8_LDB(B1, 0, 1); PG8_STAGE(PG8_SB(0, 0), b2, voffB);
            PG8_BAR; PG8_WAIT_L(0); PG8_MMA(0, 1, At, B1); PG8_BAR;
            PG8_LDA(At, 0, 1); PG8_STAGE(PG8_SA(0, 0), a2, voffA);
            PG8_BAR; PG8_WAIT_L(0); PG8_MMA(1, 0, At, B0); PG8_BAR; PG8_SCHED;
            PG8_STAGE(PG8_SB(0, 1), b2 + hstep, voffB);
            PG8_WAIT_V(6); PG8_BAR; PG8_MMA(1, 1, At, B1); PG8_BAR;
            PG8_LDB(B0, 1, 0); PG8_SCHED; PG8_LDA(At, 1, 0); PG8_STAGE(PG8_SA(0, 1), a2 + hstep, voffA);
            PG8_WAIT_L(8); PG8_BAR; PG8_WAIT_L(0); PG8_MMA(0, 0, At, B0); PG8_BAR; PG8_SCHED;
            PG8_LDB(B1, 1, 1); PG8_STAGE(PG8_SB(1, 0), b3, voffB);
            PG8_BAR; PG8_WAIT_L(0); PG8_MMA(0, 1, At, B1); PG8_BAR;
            PG8_LDA(At, 1, 1); PG8_STAGE(PG8_SA(1, 0), a3, voffA);
            PG8_BAR; PG8_WAIT_L(0); PG8_MMA(1, 0, At, B0); PG8_BAR; PG8_SCHED;
            PG8_STAGE(PG8_SB(1, 1), b3 + hstep, voffB);
            PG8_WAIT_V(6); PG8_BAR; PG8_MMA(1, 1, At, B1); PG8_BAR;
            }
        }
        if constexpr (ALIGN_EPI) { if (wr == 0) PG8_BAR; }
        if constexpr (!Epi::AFTER_DRAIN) { E(acc, cur, wr, wc, fr, fq); S.done(cur); }
        if (!has_next) break;
#pragma unroll
        for (int a = 0; a < 2; ++a)
#pragma unroll
            for (int b = 0; b < 2; ++b)
#pragma unroll
                for (int m = 0; m < 4; ++m)
#pragma unroll
                    for (int n = 0; n < 2; ++n) acc[a][b][m][n] = (f32x4){0.f, 0.f, 0.f, 0.f};
        cur = nxt; cA = nA; cB = nB; ++ui;
        if constexpr (ALIGN_EPI) { if (wr == 1) PG8_BAR; }
    }
    PG8_WAIT_V(0);
    if constexpr (!ALIGN_EPI) { if (wr == 0) PG8_BAR; }
    PG8_BAR;
    if constexpr (Epi::AFTER_DRAIN) { E.fused(acc, cur, wr, wc, fr, fq, lds, wid, lane); S.done(cur); }
#undef PG8_SA
#undef PG8_SB
#undef PG8_STAGE
#undef PG8_LDA
#undef PG8_LDB
#undef PG8_MMA
#undef PG8_WAIT_V
#undef PG8_WAIT_L
#undef PG8_BAR
#undef PG8_SCHED
}
}

constexpr int M = 8192, D = 2048, SEQ = 2048, NB = 4, FF = 5632, PLE = 256, GW = 2048, CHUNK = 128, HEADS = 16, S5G = 128, S5P = 64, S5C = 16;
constexpr float EPS = 1e-6f;
constexpr size_t MiB = 1u << 20;
constexpr size_t WS_PART0 = 0, WS_PART1 = 2 * MiB, WS_VSTAT = 4 * MiB, WS_WC = 6 * MiB, WS_PB = 8 * MiB;
constexpr size_t WS_GMIN = 16 * MiB, WS_GMOUT = 32 * MiB, WS_S5IN = 40 * MiB, WS_S5OUT = 48 * MiB, WS_FFN13 = 64 * MiB  , WS_FFN2 = 152 * MiB  , WS_PLEG = 196 * MiB  , WS_PLEP = 212 * MiB  ;
constexpr size_t WS_XB0 = 216 * MiB, WS_XB1 = 248 * MiB, WS_H = 280 * MiB  , WS_G = 368 * MiB, WS_PROJ = 400 * MiB, WS_CTL = 432 * MiB  , WS_END = 433 * MiB;
constexpr size_t CTL_ZERO_BYTES = 16384;
#ifndef PHMASK
#define PHMASK 4095
#endif
#ifndef LATE_SCRATCH
#define LATE_SCRATCH 0
#endif
#ifndef CONV_KA
#define CONV_KA 3
#endif
#ifndef SEG_B
#define SEG_B 8
#endif
#ifndef P3_BF16_RES
#define P3_BF16_RES 0
#endif
#ifndef CONV_PLAIN
#define CONV_PLAIN 0
#endif
#ifndef CONV_IMMEDIATE
#define CONV_IMMEDIATE 0
#endif
#ifndef DUP_PRO
#define DUP_PRO 0
#endif
#ifndef LATE_SET
#define LATE_SET 63
#endif
#ifndef CONV_IN_SCAN
#define CONV_IN_SCAN 0
#endif
#ifndef XB_SLEEP
#define XB_SLEEP 8
#endif
#ifndef PFB_ON
#define PFB_ON 0
#endif
#ifndef ALIGN_ON
#define ALIGN_ON true
#endif
#ifndef HALFM_ON
#define HALFM_ON true
#endif
#ifndef REP_PRO
#define REP_PRO 1
#endif
#ifndef REP_SCAN
#define REP_SCAN 1
#endif
#ifndef REP_SPAT
#define REP_SPAT 1
#endif
#ifndef REP_UP
#define REP_UP 1
#endif
#ifndef EXTRA_SYNC
#define EXTRA_SYNC 0
#endif
constexpr int MISC_OFF = 8 * 16640 + 4096, LDS_BYTES = MISC_OFF + 1024;

#define LAS __attribute__((address_space(3)))
typedef unsigned short bf16;
typedef unsigned v4u __attribute__((ext_vector_type(4)));
typedef unsigned v2u __attribute__((ext_vector_type(2)));
typedef float f32x4 __attribute__((ext_vector_type(4)));
typedef short bf16x8 __attribute__((ext_vector_type(8)));
#define LDS_WAIT() asm volatile("s_waitcnt lgkmcnt(0)" ::: "memory")
using pg8::cvt_pk_bf16; using pg8::bf_lo; using pg8::bf_hi; using pg8::gelu_tanh;

struct Params { const float* in[27]; float* out; unsigned char* ws; };
enum { I_X = 0, I_P, I_NMIX, I_NFFN, I_NPLE, I_NFIN, I_GMIN, I_LNG, I_LNB, I_WS, I_BS, I_GMOUT, I_S5IN, I_ARE, I_AIM, I_LOGDT, I_BRE, I_BIM, I_CRE, I_CIM, I_S5D, I_S5OUT, I_W1, I_W3, I_W2, I_PLEG, I_PLEP };


typedef __attribute__((address_space(4))) const unsigned char* kaptr_t;
__device__ __forceinline__ kaptr_t ka_base() { kaptr_t p = (kaptr_t)__builtin_amdgcn_kernarg_segment_ptr(); asm volatile("" : "+s"(p)); return p; }
#define INP(i) (*(const float* const __attribute__((address_space(4)))*)(ka_base() + 8 * (i)))
#define OUTP() (*(float* const __attribute__((address_space(4)))*)(ka_base() + 8 * 27))
#define WSP() (*(unsigned char* const __attribute__((address_space(4)))*)(ka_base() + 8 * 28))

__device__ __forceinline__ float wave_sum(float v) {
#pragma unroll
    for (int o = 1; o < 64; o <<= 1) v += __shfl_xor(v, o);
    return v;
}

__device__ __forceinline__ void tr_issue(const float* W, int ldn, int nblk, int item, int lane, f32x4 (&v)[16]) {
    const int kb = item / nblk, nb = item - kb * nblk, k0 = 64 * kb, n0 = 64 * nb;
    const int r = lane >> 4, q = lane & 15;
    const float* src = W + (size_t)(k0 + 2 * r) * ldn + n0 + 4 * q;
#pragma unroll
    for (int i = 0; i < 16; ++i) v[i] = *(const f32x4*)(src + (size_t)(8 * (i >> 1) + (i & 1)) * ldn);
}
__device__ __forceinline__ void tr_finish(int K, int nblk, const float* ks, bf16* WT, int mode, LAS unsigned* scr, int item, int lane, f32x4 (&v)[16]) {
    const int kb = item / nblk, nb = item - kb * nblk, k0 = 64 * kb, n0 = 64 * nb;
    const int r = lane >> 4, q = lane & 15;
    if (ks) {
#pragma unroll
        for (int ip = 0; ip < 8; ++ip) { const float s0 = ks[k0 + 8 * ip + 2 * r], s1 = ks[k0 + 8 * ip + 2 * r + 1]; v[2 * ip] *= s0; v[2 * ip + 1] *= s1; } }
#pragma unroll
    for (int ip = 0; ip < 8; ++ip) { v4u w; w.x = cvt_pk_bf16(v[2 * ip][0], v[2 * ip + 1][0]); w.y = cvt_pk_bf16(v[2 * ip][1], v[2 * ip + 1][1]); w.z = cvt_pk_bf16(v[2 * ip][2], v[2 * ip + 1][2]); w.w = cvt_pk_bf16(v[2 * ip][3], v[2 * ip + 1][3]);
        *(LAS v4u*)(scr + (4 * ip + r) * 68 + 4 * q) = w; }
    LDS_WAIT();
    const int c = lane & 7, ngl = lane >> 3;
    const int r0 = (mode == 0) ? n0 : ((n0 >> 7) * 256 + (n0 & 127) + (mode == 2 ? 128 : 0));
#pragma unroll
    for (int rd = 0; rd < 2; ++rd) { const int ng = ngl + 8 * rd; v4u m[4];
#pragma unroll
        for (int j = 0; j < 4; ++j) m[j] = *(const LAS v4u*)(scr + (4 * c + j) * 68 + 4 * ng);
#pragma unroll
        for (int i = 0; i < 4; ++i) { v4u o; o.x = m[0][i]; o.y = m[1][i]; o.z = m[2][i]; o.w = m[3][i]; *(v4u*)(WT + (size_t)(r0 + 4 * ng + i) * K + k0 + 8 * c) = o; } }
    LDS_WAIT();
}
__device__ __forceinline__ void tr_item(const float* W, int K, int ldn, int nblk, const float* ks, bf16* WT, int mode, LAS unsigned* scr, int item, int lane) {
    f32x4 v[16]; tr_issue(W, ldn, nblk, item, lane, v); tr_finish(K, nblk, ks, WT, mode, scr, item, lane, v);
}
constexpr int L1C_B = 32 * 32, L1C_F = 32 * 88, L1C_2 = 88 * 32;
constexpr int LN0 = (LATE_SET & 1) ? L1C_B : 0, LN1 = (LATE_SET & 2) ? L1C_B : 0, LN2 = (LATE_SET & 4) ? L1C_F : 0, LN3 = (LATE_SET & 8) ? L1C_F : 0, LN4 = (LATE_SET & 16) ? L1C_2 : 0, LN5 = (LATE_SET & 32) ? L1C_B : 0, L1_NIT = LN0 + LN1 + LN2 + LN3 + LN4 + LN5;
struct TrD { const float* W; const float* ks; bf16* WT; int K, ldn, nblk, mode, item; };
__device__ __forceinline__ TrD l1_desc(int it, unsigned char* ws) {
    TrD d; int r = it;
#define TD(cnt, W_, K_, LDN_, NBLK_, KS_, DST_, MODE_) if (r < (cnt)) { d.W = W_; d.K = K_; d.ldn = LDN_; d.nblk = NBLK_; d.ks = KS_; d.WT = (bf16*)(ws + (DST_)); d.mode = MODE_; d.item = r; return d; } r -= (cnt);
    TD(LN0, INP(I_S5OUT), D, 4096, 32, nullptr, WS_S5OUT, 1)
    TD(LN1, INP(I_S5OUT) + 2048, D, 4096, 32, nullptr, WS_S5OUT, 2)
    TD(LN2, INP(I_W1) + (size_t)D * FF, D, FF, 88, INP(I_NFFN) + D, WS_FFN13 + 44 * MiB, 1)
    TD(LN3, INP(I_W3) + (size_t)D * FF, D, FF, 88, INP(I_NFFN) + D, WS_FFN13 + 44 * MiB, 2)
    TD(LN4, INP(I_W2) + (size_t)D * FF, FF, D, 32, nullptr, WS_FFN2 + 22 * MiB, 0)
#undef TD
    d.W = INP(I_PLEG) + (size_t)D * D; d.K = D; d.ldn = D; d.nblk = 32; d.ks = INP(I_NPLE) + D; d.WT = (bf16*)(ws + (LATE_SCRATCH ? (size_t)440 * MiB : WS_PLEG + 8 * MiB)); d.mode = 0; d.item = r; return d;
}

__device__ __forceinline__ void prologue(LAS unsigned char* lds, int tid_in, int lane_in, int wave) {
    int tid = tid_in; asm volatile("" : "+v"(tid)); const int lane = tid & 63; (void)lane_in;
    unsigned char* ws = WSP();
    LAS unsigned* scr = (LAS unsigned*)(lds + wave * 16384);
    const int gw = blockIdx.x * 8 + wave, NGW = gridDim.x * 8;
    constexpr int C_A = 32 * 64, C_B = 32 * 32, C_F = 32 * 88, C_2 = 88 * 32, C_P = 4 * 32;
    constexpr int LS = CONV_IN_SCAN ? LATE_SET : 0;
    constexpr int PN0 = (LS & 1) ? 0 : C_B, PN1 = (LS & 2) ? 0 : C_B, PN2 = (LS & 4) ? 0 : C_F, PN3 = (LS & 8) ? 0 : C_F, PN4 = (LS & 16) ? 0 : C_2, PN5 = ((LS & 32) && !DUP_PRO) ? 0 : C_B;
    constexpr int NITEMS = C_A + 2 * C_F + 2 * C_P + 3 * C_B + C_2 + PN0 + PN1 + PN2 + PN3 + PN4 + PN5;
    for (int it = gw; it < NITEMS; it += NGW) {
        int r = it;
#define TR(cnt, W, K, LDN, NBLK, KS, DST, MODE) if (r < (cnt)) { tr_item(W, K, LDN, NBLK, KS, (bf16*)(ws + (DST)), MODE, scr, r, lane); continue; } r -= (cnt);
        TR(C_A, INP(I_GMIN), D, 4096, 64, INP(I_NMIX), WS_GMIN, 0)
        TR(C_P, INP(I_PLEP), PLE, D, 32, nullptr, WS_PLEP, 0)
        TR(C_F, INP(I_W1), D, FF, 88, INP(I_NFFN), WS_FFN13, 1)
        TR(C_F, INP(I_W3), D, FF, 88, INP(I_NFFN), WS_FFN13, 2)
        TR(C_B, INP(I_GMOUT), D, D, 32, nullptr, WS_GMOUT, 0)
        TR(C_2, INP(I_W2), FF, D, 32, nullptr, WS_FFN2, 0)
        TR(C_B, INP(I_PLEG), D, D, 32, INP(I_NPLE), WS_PLEG, 0)
        TR(C_B, INP(I_S5IN), D, D, 32, INP(I_NMIX) + D, WS_S5IN, 0)
        TR(C_P, INP(I_PLEP) + (size_t)PLE * D, PLE, D, 32, nullptr, WS_PLEP + 1 * MiB, 0)
        TR(PN0, INP(I_S5OUT), D, 4096, 32, nullptr, WS_S5OUT, 1)
        TR(PN1, INP(I_S5OUT) + 2048, D, 4096, 32, nullptr, WS_S5OUT, 2)
        TR(PN2, INP(I_W1) + (size_t)D * FF, D, FF, 88, INP(I_NFFN) + D, WS_FFN13 + 44 * MiB, 1)
        TR(PN3, INP(I_W3) + (size_t)D * FF, D, FF, 88, INP(I_NFFN) + D, WS_FFN13 + 44 * MiB, 2)
        TR(PN4, INP(I_W2) + (size_t)D * FF, FF, D, 32, nullptr, WS_FFN2 + 22 * MiB, 0)
        TR(PN5, INP(I_PLEG) + (size_t)D * D, D, D, 32, INP(I_NPLE) + D, WS_PLEG + 8 * MiB, 0)
    }
    {   const float* x = INP(I_X); bf16* xb = (bf16*)(ws + WS_XB0); float* part = (float*)(ws + WS_PART0);
        for (int m = gw; m < M; m += NGW) {
            const f32x4* xr = (const f32x4*)(x + (size_t)m * D) + lane; v2u* o = (v2u*)(xb + (size_t)m * D) + lane; float s = 0.f;
#pragma unroll
            for (int j = 0; j < 8; ++j) { const f32x4 v = xr[64 * j]; s += (v[0] * v[0] + v[1] * v[1]) + (v[2] * v[2] + v[3] * v[3]); v2u w; w.x = cvt_pk_bf16(v[0], v[1]); w.y = cvt_pk_bf16(v[2], v[3]); o[64 * j] = w; }
            s = wave_sum(s);
            if (lane < 32) part[(size_t)m * 32 + lane] = (lane == 0) ? s : 0.f;
        } }
    {   const f32x4* p4 = (const f32x4*)INP(I_P); v2u* o = (v2u*)(ws + WS_PB); const int n4 = 2 * M * PLE / 4;
        for (int i = blockIdx.x * 512 + tid; i < n4; i += gridDim.x * 512) { const f32x4 v = p4[i]; v2u w; w.x = cvt_pk_bf16(v[0], v[1]); w.y = cvt_pk_bf16(v[2], v[3]); o[i] = w; } }
    {   const float* w = INP(I_WS); bf16* o = (bf16*)(ws + WS_WC);
        for (int i = blockIdx.x * 512 + tid; i < HEADS * CHUNK * CHUNK; i += gridDim.x * 512) { const int s = i & 127, t = (i >> 7) & 127; const float v = (s <= t) ? w[i] : 0.f; o[i] = (bf16)(cvt_pk_bf16(v, v) & 0xffffu); } }
}

__device__ __forceinline__ void spatial_phase(LAS unsigned char* lds, int tid_in, int lane_in, int wave) {
    int tid = tid_in; asm volatile("" : "+v"(tid)); const int lane = tid & 63; (void)lane_in;
    unsigned char* ws = WSP();
    const bf16* zb = (const bf16*)(ws + WS_H); bf16* gb = (bf16*)(ws + WS_G); const bf16* wc = (const bf16*)(ws + WS_WC); const float* vstat = (const float*)(ws + WS_VSTAT);
    const float* lng = INP(I_LNG); const float* lnb = INP(I_LNB); const float* bs = INP(I_BS);
    constexpr int VP = 136;
    LAS bf16* VT = (LAS bf16*)lds; LAS float* ST = (LAS float*)(lds + 128 * VP * 2);
    const int s = tid & 127, q4 = tid >> 7, r = lane & 15, kq = lane >> 4, G = gridDim.x;
    v4u vw[4];
    const int PER = (64 * HEADS) / G, ubase = (PER >= 1 && PER <= 16 && (16 % PER) == 0 && PER * G == 64 * HEADS) ? (int)blockIdx.x * PER : -1;
    {   const int unit = (ubase >= 0) ? ubase : (int)blockIdx.x; if (unit < 64 * HEADS) { const bf16* vp = zb + (size_t)((unit >> 4) * CHUNK + s) * 4096 + GW + (unit & 15) * 128 + q4 * 32;
#pragma unroll
            for (int c = 0; c < 4; ++c) vw[c] = *(const v4u*)(vp + 8 * c); } }
    const int ustep = (ubase >= 0) ? 1 : G, uend = (ubase >= 0) ? ubase + PER : 64 * HEADS;
    for (int unit = (ubase >= 0) ? ubase : (int)blockIdx.x; unit < uend; unit += ustep) {
        const int h = unit & 15, tok0 = (unit >> 4) * CHUNK;
        if (tid < 128 && (ubase < 0 || unit == ubase)) { const f32x4* sp = (const f32x4*)(vstat + (size_t)(tok0 + tid) * 64); float s1 = 0.f, s2 = 0.f;
#pragma unroll
            for (int j = 0; j < 16; ++j) { const f32x4 v = sp[j]; s1 += v[0] + v[2]; s2 += v[1] + v[3]; }
            const float mean = s1 * (1.0f / GW), var = s2 * (1.0f / GW) - mean * mean; ST[2 * tid] = mean; ST[2 * tid + 1] = rsqrtf(var + EPS); }
        __syncthreads();
        {   const float mean = ST[2 * s], rstd = ST[2 * s + 1];
#pragma unroll
            for (int c = 0; c < 4; ++c) { const v4u w = vw[c]; const int d0 = q4 * 32 + 8 * c;
                const f32x4 g0 = *(const f32x4*)(lng + h * 128 + d0), g1 = *(const f32x4*)(lng + h * 128 + d0 + 4), b0 = *(const f32x4*)(lnb + h * 128 + d0), b1 = *(const f32x4*)(lnb + h * 128 + d0 + 4);
                float v[8] = {bf_lo(w.x), bf_hi(w.x), bf_lo(w.y), bf_hi(w.y), bf_lo(w.z), bf_hi(w.z), bf_lo(w.w), bf_hi(w.w)};
#pragma unroll
                for (int j = 0; j < 8; ++j) { const float g = j < 4 ? g0[j & 3] : g1[j & 3], b = j < 4 ? b0[j & 3] : b1[j & 3]; const float y = (v[j] - mean) * rstd * g + b;
                    VT[(d0 + j) * VP + s] = (bf16)(cvt_pk_bf16(y, y) & 0xffffu); } } }
        {   const int nu = unit + ustep; if (nu < uend) { const bf16* vp = zb + (size_t)((nu >> 4) * CHUNK + s) * 4096 + GW + (nu & 15) * 128 + q4 * 32;
#pragma unroll
                for (int c = 0; c < 4; ++c) vw[c] = *(const v4u*)(vp + 8 * c); } }
        __syncthreads();
        {   const int t0 = 16 * wave, nks = (wave >> 1) + 1;
            const int tok = tok0 + t0 + r; const float bias = bs[h * CHUNK + t0 + r];
            v2u uw[8];
#pragma unroll
            for (int dt = 0; dt < 8; ++dt) uw[dt] = *(const v2u*)(zb + (size_t)tok * 4096 + h * 128 + dt * 16 + 4 * kq);
            f32x4 acc[8];
#pragma unroll
            for (int i = 0; i < 8; ++i) acc[i] = (f32x4){0.f, 0.f, 0.f, 0.f};
            for (int ks = 0; ks < nks; ++ks) {
                const bf16x8 yf = *(const bf16x8*)(wc + ((size_t)h * CHUNK + t0 + r) * CHUNK + 32 * ks + 8 * kq);
#pragma unroll
                for (int dt = 0; dt < 8; ++dt) { const bf16x8 xf = *(const LAS bf16x8*)(VT + (dt * 16 + r) * VP + 32 * ks + 8 * kq); acc[dt] = __builtin_amdgcn_mfma_f32_16x16x32_bf16(xf, yf, acc[dt], 0, 0, 0); }
            }
#pragma unroll
            for (int dt = 0; dt < 8; ++dt) { const int col = h * 128 + dt * 16 + 4 * kq;
                v2u o; o.x = cvt_pk_bf16(bf_lo(uw[dt].x) * (acc[dt][0] + bias), bf_hi(uw[dt].x) * (acc[dt][1] + bias)); o.y = cvt_pk_bf16(bf_lo(uw[dt].y) * (acc[dt][2] + bias), bf_hi(uw[dt].y) * (acc[dt][3] + bias));
                *(v2u*)(gb + (size_t)tok * D + col) = o; }
        }
    }
    __syncthreads();
}

constexpr int SC_BP = 20, SC_SP = 136, SC_STRIDE = 16640, SC_E_OFF = 8 * SC_STRIDE;
template <bool EMIT, bool CONV> __device__ __forceinline__ void scan_segment(LAS float* BU, LAS bf16* SL, LAS bf16* YB, const bf16* up, bf16* ofl, const bf16x8 (&Bf)[8], const bf16x8 (&Cf)[4], const bf16x8 Df,
                                                                  const float lr, const float li, float& sr, float& si, const int lane, unsigned char* ws, const int gw, const int NGW, const int NBT) {
    constexpr int BP = SC_BP, SP = SC_SP;
    const int c = lane & 15, kq = lane >> 4;
    v4u un[4];
#pragma unroll
    for (int c4 = 0; c4 < 4; ++c4) un[c4] = *(const v4u*)(up + (size_t)(c4 * 16) * D);
    f32x4 cv[CONV ? 16 : 1]; int pend = -1;
    for (int bt = 0; bt <= NBT; ++bt) {
        if constexpr (CONV) {
            if (pend >= 0) { const TrD d = l1_desc(pend, ws); tr_finish(d.K, d.nblk, d.ks, d.WT, d.mode, (LAS unsigned*)BU, d.item, lane, cv); pend = -1; }
            const int it = gw + bt * NGW;
            if (bt < NBT && it < L1_NIT) { const TrD d = l1_desc(it, ws); tr_issue(d.W, d.ldn, d.nblk, d.item, lane, cv); pend = it; }
#if CONV_IMMEDIATE
            if (pend >= 0) { const TrD d = l1_desc(pend, ws); tr_finish(d.K, d.nblk, d.ks, d.WT, d.mode, (LAS unsigned*)BU, d.item, lane, cv); pend = -1; }
#endif
        }
        v4u uc[4];
#pragma unroll
        for (int c4 = 0; c4 < 4; ++c4) uc[c4] = un[c4];
        if (EMIT && bt > 0) { const v4u y0 = *(const LAS v4u*)(YB + lane * 8), y1 = *(const LAS v4u*)(YB + 512 + lane * 8); bf16* o = ofl + (size_t)(bt - 1) * 64 * D; *(v4u*)o = y0; *(v4u*)(o + (size_t)32 * D) = y1; }
        if (bt == NBT) break;
        if (bt + 1 < NBT) {
#pragma unroll
            for (int c4 = 0; c4 < 4; ++c4) un[c4] = *(const v4u*)(up + (size_t)(((bt + 1) * 4 + c4) * 16) * D); }
#pragma unroll
        for (int c4 = 0; c4 < 4; ++c4) {
            v4u uw = uc[c4]; if (kq >= 2) uw = (v4u){0u, 0u, 0u, 0u};
            const bf16x8 Uf = __builtin_bit_cast(bf16x8, uw);
#pragma unroll
            for (int j = 0; j < 8; ++j) { const f32x4 d4 = __builtin_amdgcn_mfma_f32_16x16x32_bf16(Uf, Bf[j], (f32x4){0.f, 0.f, 0.f, 0.f}, 0, 0, 0); *(LAS f32x4*)(BU + (16 * j + c) * BP + 4 * kq) = d4; }
            LDS_WAIT();
            f32x4 bre[4], bim[4];
#pragma unroll
            for (int q = 0; q < 4; ++q) { bre[q] = *(const LAS f32x4*)(BU + lane * BP + 4 * q); bim[q] = *(const LAS f32x4*)(BU + (64 + lane) * BP + 4 * q); }
#pragma unroll
            for (int t = 0; t < 16; ++t) { const float nr = lr * sr - li * si + bre[t >> 2][t & 3], ni = lr * si + li * sr + bim[t >> 2][t & 3]; sr = nr; si = ni;
                if (EMIT) *(LAS unsigned*)(SL + t * SP + 2 * lane) = cvt_pk_bf16(sr, si); }
            if (EMIT) {
                LDS_WAIT();
                f32x4 y = __builtin_amdgcn_mfma_f32_16x16x32_bf16(Uf, Df, (f32x4){0.f, 0.f, 0.f, 0.f}, 0, 0, 0);
#pragma unroll
                for (int ks = 0; ks < 4; ++ks) { const bf16x8 xs = *(const LAS bf16x8*)(SL + c * SP + 32 * ks + 8 * kq); y = __builtin_amdgcn_mfma_f32_16x16x32_bf16(xs, Cf[ks], y, 0, 0, 0); }
#pragma unroll
                for (int i = 0; i < 4; ++i) { const float gy = gelu_tanh(y[i]); YB[(c4 * 16 + 4 * kq + i) * 16 + c] = (bf16)(cvt_pk_bf16(gy, gy) & 0xffffu); }
            }
            LDS_WAIT();
        }
    }
}
__device__ __forceinline__ void scan_phase(LAS unsigned char* lds, int tid_in, int lane_in, int wave) {
    int tid = tid_in; asm volatile("" : "+v"(tid)); const int lane = tid & 63; (void)lane_in;
    unsigned char* ws = WSP();
    const bf16* ub = (const bf16*)(ws + WS_H); bf16* gb = (bf16*)(ws + WS_G);
    LAS float* BU = (LAS float*)(lds + wave * SC_STRIDE); LAS bf16* SL = (LAS bf16*)(lds + wave * SC_STRIDE + 128 * SC_BP * 4); LAS bf16* YB = (LAS bf16*)(lds + wave * SC_STRIDE + 128 * SC_BP * 4 + 16 * SC_SP * 2);
    const int c = lane & 15, kq = lane >> 4, seq = wave >> 2, seg = wave & 3;
    LAS float* EB = (LAS float*)(lds + SC_E_OFF) + seq * 4 * 128;
    for (int task = blockIdx.x * 2 + seq; task < NB * S5G; task += gridDim.x * 2) {
        const int b = task >> 7, g = task & 127;
        const float dt = __expf(INP(I_LOGDT)[g]);
        float lr, li;
        {   const float are = INP(I_ARE)[g * S5P + lane], aim = INP(I_AIM)[g * S5P + lane]; const float mag = expf(are * dt); float sn, cs; sincosf(aim * dt, &sn, &cs); lr = mag * cs; li = mag * sn; }
        bf16x8 Bf[8], Cf[4], Df;
#pragma unroll
        for (int j = 0; j < 8; ++j) { const int R = 16 * j + c, pp = R & 63; const bool isim = R >= 64;
            const float are = INP(I_ARE)[g * S5P + pp], aim = INP(I_AIM)[g * S5P + pp]; const float mag = expf(are * dt); float sn, cs; sincosf(aim * dt, &sn, &cs);
            const float nr = mag * cs - 1.0f, ni = mag * sn, inv = 1.0f / (are * are + aim * aim);
            const float cr = (nr * are + ni * aim) * inv, ci = (ni * are - nr * aim) * inv;
            float v[8];
            if (kq < 2) { const float* pbr = INP(I_BRE) + (size_t)(g * S5P + pp) * S5C + 8 * kq; const float* pbi = INP(I_BIM) + (size_t)(g * S5P + pp) * S5C + 8 * kq;
                const f32x4 br0 = *(const f32x4*)pbr, br1 = *(const f32x4*)(pbr + 4), bi0 = *(const f32x4*)pbi, bi1 = *(const f32x4*)(pbi + 4);
#pragma unroll
                for (int e = 0; e < 8; ++e) { const float bre = e < 4 ? br0[e & 3] : br1[e & 3], bim = e < 4 ? bi0[e & 3] : bi1[e & 3]; v[e] = isim ? (cr * bim + ci * bre) : (cr * bre - ci * bim); }
            } else {
#pragma unroll
                for (int e = 0; e < 8; ++e) v[e] = 0.f; }
            v4u w; w.x = cvt_pk_bf16(v[0], v[1]); w.y = cvt_pk_bf16(v[2], v[3]); w.z = cvt_pk_bf16(v[4], v[5]); w.w = cvt_pk_bf16(v[6], v[7]); Bf[j] = __builtin_bit_cast(bf16x8, w); }
#pragma unroll
        for (int ks = 0; ks < 4; ++ks) { const size_t o = (size_t)(g * S5C + c) * S5P + 16 * ks + 4 * kq; const f32x4 cr4 = *(const f32x4*)(INP(I_CRE) + o), ci4 = *(const f32x4*)(INP(I_CIM) + o);
            v4u w; w.x = cvt_pk_bf16(cr4[0], -ci4[0]); w.y = cvt_pk_bf16(cr4[1], -ci4[1]); w.z = cvt_pk_bf16(cr4[2], -ci4[2]); w.w = cvt_pk_bf16(cr4[3], -ci4[3]); Cf[ks] = __builtin_bit_cast(bf16x8, w); }
        {   const float dv = INP(I_S5D)[g * S5C + c]; float v[8];
#pragma unroll
            for (int e = 0; e < 8; ++e) v[e] = (kq < 2 && (8 * kq + e) == c) ? dv : 0.f;
            v4u w; w.x = cvt_pk_bf16(v[0], v[1]); w.y = cvt_pk_bf16(v[2], v[3]); w.z = cvt_pk_bf16(v[4], v[5]); w.w = cvt_pk_bf16(v[6], v[7]); Df = __builtin_bit_cast(bf16x8, w); }
        const int nbt = (seg < 3) ? SEG_B : (SEQ / 64 - 3 * SEG_B); const int t0 = seg * (SEG_B * 64);
        const bf16* up = ub + (size_t)(b * SEQ + t0 + c) * D + g * S5C + 8 * (kq & 1);
        bf16* ofl = gb + (size_t)(b * SEQ + t0 + (lane >> 1)) * D + g * S5C + (lane & 1) * 8;
        float sr = 0.f, si = 0.f;
        const int gw = blockIdx.x * 8 + wave, NGW = gridDim.x * 8;
#if CONV_PLAIN
        constexpr int KA = CONV_KA;
        for (int k = 0; k < KA; ++k) { const int it = gw + k * NGW; if (it < L1_NIT) { const TrD d = l1_desc(it, ws); tr_item(d.W, d.K, d.ldn, d.nblk, d.ks, d.WT, d.mode, (LAS unsigned*)BU, d.item, lane); } }
        if (seg < 3) scan_segment<false, false>(BU, SL, YB, up, ofl, Bf, Cf, Df, lr, li, sr, si, lane, ws, gw, NGW, nbt);
        else { for (int it = KA * NGW + (int)blockIdx.x * 2 + seq; it < L1_NIT; it += (int)gridDim.x * 2) { const TrD d = l1_desc(it, ws); tr_item(d.W, d.K, d.ldn, d.nblk, d.ks, d.WT, d.mode, (LAS unsigned*)BU, d.item, lane); } }
        if (false)
#endif
        if (seg < 3) scan_segment<false, CONV_IN_SCAN != 0>(BU, SL, YB, up, ofl, Bf, Cf, Df, lr, li, sr, si, lane, ws, gw, NGW, nbt);
        else if (CONV_IN_SCAN) { for (int bt = 0; bt < 8; ++bt) { const int it = gw + bt * NGW; if (it < L1_NIT) { const TrD d = l1_desc(it, ws); tr_item(d.W, d.K, d.ldn, d.nblk, d.ks, d.WT, d.mode, (LAS unsigned*)BU, d.item, lane); } } }
        EB[(seg * 64 + lane) * 2] = sr; EB[(seg * 64 + lane) * 2 + 1] = si;
        __syncthreads();
        float Lr = 1.f, Li = 0.f;
        {   float pr = lr, pi = li;
#pragma unroll
            for (int q = 0; q < 11; ++q) { if (((SEG_B * 64) >> q) & 1) { const float nr = Lr * pr - Li * pi, ni = Lr * pi + Li * pr; Lr = nr; Li = ni; }
                const float sr2 = pr * pr - pi * pi, si2 = 2.0f * pr * pi; pr = sr2; pi = si2; } }
        sr = 0.f; si = 0.f;
        for (int j = 0; j < seg; ++j) { const float er = EB[(j * 64 + lane) * 2], ei = EB[(j * 64 + lane) * 2 + 1]; const float nr = Lr * sr - Li * si + er, ni = Lr * si + Li * sr + ei; sr = nr; si = ni; }
        scan_segment<true, false>(BU, SL, YB, up, ofl, Bf, Cf, Df, lr, li, sr, si, lane, ws, gw, NGW, nbt);
        __syncthreads();
    }
}

__device__ __forceinline__ void final_norm(int lane_in, int wave) {
    int lane = lane_in; asm volatile("" : "+v"(lane));
    const int gw = blockIdx.x * 8 + wave, NGW = gridDim.x * 8; const f32x4* g4 = (const f32x4*)INP(I_NFIN) + lane;
    for (int m = gw; m < M; m += NGW) {
        f32x4* xr = (f32x4*)(OUTP() + (size_t)m * D) + lane; f32x4 v[8]; float s = 0.f;
#pragma unroll
        for (int j = 0; j < 8; ++j) { v[j] = xr[64 * j]; s += (v[j][0] * v[j][0] + v[j][1] * v[j][1]) + (v[j][2] * v[j][2] + v[j][3] * v[j][3]); }
        const float rs = rsqrtf(wave_sum(s) * (1.0f / D) + EPS);
#pragma unroll
        for (int j = 0; j < 8; ++j) xr[64 * j] = v[j] * rs * g4[64 * j];
    }
}

#define RLX_AGENT __ATOMIC_RELAXED, __HIP_MEMORY_SCOPE_AGENT
#define XB_TMO      128
#define XB_XCNT(j)  (256  + 64 * (j))
#define XB_XSUB(j)  (1280 + 64 * (j))
#define XB_XGEN(j)  (2304 + 64 * (j))
#define XB_TOP      3328
#define XB_TOPGEN   3392
#define XCD_BAR_WORDS 3456
#define XB_SPIN_CAP (1u << 18)

__device__ __forceinline__ unsigned xb_ld(unsigned* p)              { return __hip_atomic_load(p, __ATOMIC_RELAXED, __HIP_MEMORY_SCOPE_AGENT); }
__device__ __forceinline__ unsigned xb_add(unsigned* p, unsigned v) { return __hip_atomic_fetch_add(p, v, __ATOMIC_RELAXED, __HIP_MEMORY_SCOPE_AGENT); }
__device__ __forceinline__ unsigned xb_xcc_id() { return (unsigned)__builtin_amdgcn_s_getreg((3 << 11) | 20) & 0xFu; }
#define XB_SPIN(cond, bar) do { unsigned _sp = 0; while (cond) { __builtin_amdgcn_s_sleep(XB_SLEEP); \
    if ((++_sp & 255u) == 0u) { if (xb_ld(&(bar)[XB_TMO])) break; if (_sp > XB_SPIN_CAP) { atomicAdd(&(bar)[XB_TMO], 1u); break; } } } } while (0)

struct XcdBarrier {
    unsigned* bar; unsigned x;
    volatile LAS unsigned* st;
};

__device__ __forceinline__ XcdBarrier xcd_barrier_post(unsigned* bar, volatile LAS unsigned* st) {
    XcdBarrier b; b.bar = bar; b.x = xb_xcc_id(); b.st = st;
    if (threadIdx.x == 0) (void)xb_add(&bar[XB_XCNT(b.x)], 1u);
    return b;
}
__device__ __forceinline__ void xcd_barrier_complete(unsigned* bar, unsigned x, unsigned& nloc, unsigned& nx) {
    const unsigned G = gridDim.x * gridDim.y * gridDim.z;
    unsigned sum, cnt, mine, sp = 0u;
    for (;;) {
        sum = 0u; cnt = 0u; mine = 0u;
#pragma unroll
        for (unsigned j = 0; j < 16; ++j) { const unsigned c = xb_ld(&bar[XB_XCNT(j)]); sum += c; cnt += (c > 0u) ? 1u : 0u; mine = (j == x) ? c : mine; }
        if (sum == G) break;
        __builtin_amdgcn_s_sleep(1);
        if ((++sp & 255u) == 0u) { if (xb_ld(&bar[XB_TMO])) break; if (sp > XB_SPIN_CAP) { atomicAdd(&bar[XB_TMO], 1u); break; } }
    }
    nloc = mine > 0u ? mine : 1u; nx = cnt > 0u ? cnt : 1u;
}

__device__ __forceinline__ void xcd_barrier(const XcdBarrier& b) {
    asm volatile("s_waitcnt vmcnt(0)" ::: "memory");
    __syncthreads();
    if (threadIdx.x == 0) {
        unsigned* bar = b.bar;
        __builtin_amdgcn_s_waitcnt(0);
        unsigned nloc = b.st[0], nx = b.st[1];
        if (nloc == 0u) { xcd_barrier_complete(bar, b.x, nloc, nx); b.st[0] = nloc; b.st[1] = nx; }
        const unsigned old = xb_add(&bar[XB_XSUB(b.x)], 1u);
        const unsigned gen = old / nloc;
        if (old + 1u == (gen + 1u) * nloc) {
            __builtin_amdgcn_fence(__ATOMIC_RELEASE, "agent");
            asm volatile("s_waitcnt vmcnt(0)" ::: "memory");
            const unsigned og = xb_add(&bar[XB_TOP], 1u);
            const unsigned tg = og / nx;
            if (og + 1u == (tg + 1u) * nx) xb_add(&bar[XB_TOPGEN], 1u);
            else XB_SPIN(xb_ld(&bar[XB_TOPGEN]) == tg, bar);
            __builtin_amdgcn_fence(__ATOMIC_ACQUIRE, "agent");
            xb_add(&bar[XB_XGEN(b.x)], 1u);
            asm volatile("s_waitcnt vmcnt(0)" ::: "memory");
        } else {
            XB_SPIN(xb_ld(&bar[XB_XGEN(b.x)]) == gen, bar);
            __builtin_amdgcn_fence(__ATOMIC_ACQUIRE, "agent");
            asm volatile("s_waitcnt vmcnt(0)" ::: "memory");
        }
    }
    __syncthreads();
}

__device__ __forceinline__ void prefetch_b0(LAS unsigned char* lds, const pg8::bf16_t* Bt, int K, int N, int wave) {
#if PFB_ON
    pg8::StaticOrder S; S.init(M, N, (int)gridDim.x, (int)blockIdx.x); pg8::Unit u; if (!S.next(0, u)) return;
    const int tid = wave * 64 + pg8::lane_id_now();
    const char* base = (const char*)Bt + ((size_t)u.pn * 256 + (tid & 255)) * K * 2 + (tid >> 8) * 256;
    __builtin_amdgcn_global_load_lds((const unsigned*)base, (LAS unsigned*)(lds + 131072 + wave * 256), 4, 0, 0);
    __builtin_amdgcn_global_load_lds((const unsigned*)(base + 128), (LAS unsigned*)(lds + 131072 + wave * 256), 4, 0, 0);
#endif
}
struct EpiFinal {
    static constexpr bool PERM = true, AFTER_DRAIN = true;
    const pg8::bf16_t* xin_b; float* out; float* part_out; const float* part_in; const pg8::bf16_t* proj; const float* gfin; XcdBarrier bar;
    __device__ __forceinline__ void fused(pg8::f32x4 (&acc)[2][2][4][2], const pg8::Unit& u, int wr, int wc, int fr, int fq, LAS unsigned char*, int, int) const {
        using namespace pg8;
        const int row0 = u.pm * BM + wr * 64 + fr, col0 = u.pn * BM + wc * 32 + 8 * fq;
#pragma unroll
        for (int ai = 0; ai < 2; ++ai)
#pragma unroll
            for (int m = 0; m < 4; ++m) { const int row = row0 + ai * HALF + m * 16;
                const float rs = row_rstd<32>(part_in, row, fq);
                const size_t off = (size_t)row * DM + col0; float ss = 0.f;
#pragma unroll
                for (int bj = 0; bj < 2; ++bj) { const size_t o = off + bj * HALF;
                    const u32x4 xw = *(const u32x4*)(xin_b + o); const u32x4 pw = *(const u32x4*)(proj + o); const pg8::f32x4 a0 = acc[ai][bj][m][0], a1 = acc[ai][bj][m][1]; pg8::f32x4 n0, n1;
                    n0[0] = bf_lo(xw.x) + fast_sigmoid(a0[0] * rs) * bf_lo(pw.x); n0[1] = bf_hi(xw.x) + fast_sigmoid(a0[1] * rs) * bf_hi(pw.x);
                    n0[2] = bf_lo(xw.y) + fast_sigmoid(a0[2] * rs) * bf_lo(pw.y); n0[3] = bf_hi(xw.y) + fast_sigmoid(a0[3] * rs) * bf_hi(pw.y);
                    n1[0] = bf_lo(xw.z) + fast_sigmoid(a1[0] * rs) * bf_lo(pw.z); n1[1] = bf_hi(xw.z) + fast_sigmoid(a1[1] * rs) * bf_hi(pw.z);
                    n1[2] = bf_lo(xw.w) + fast_sigmoid(a1[2] * rs) * bf_lo(pw.w); n1[3] = bf_hi(xw.w) + fast_sigmoid(a1[3] * rs) * bf_hi(pw.w);
                    acc[ai][bj][m][0] = n0; acc[ai][bj][m][1] = n1;
                    ss += ((n0[0] * n0[0] + n0[1] * n0[1]) + (n0[2] * n0[2] + n0[3] * n0[3])) + ((n1[0] * n1[0] + n1[1] * n1[1]) + (n1[2] * n1[2] + n1[3] * n1[3])); }
                ss += __shfl_xor(ss, 16); ss += __shfl_xor(ss, 32);
                if (fq == 0) part_out[(size_t)row * 32 + u.pn * 4 + wc] = ss;
                asm volatile("" ::: "memory"); }
        xcd_barrier(bar);
#pragma unroll
        for (int ai = 0; ai < 2; ++ai)
#pragma unroll
            for (int m = 0; m < 4; ++m) { const int row = row0 + ai * HALF + m * 16;
                const float rs = row_rstd<32>(part_out, row, fq);
                const size_t off = (size_t)row * DM + col0;
#pragma unroll
                for (int bj = 0; bj < 2; ++bj) { const int cc = col0 + bj * HALF; const pg8::f32x4 g0 = *(const pg8::f32x4*)(gfin + cc), g1 = *(const pg8::f32x4*)(gfin + cc + 4);
                    *(pg8::f32x4*)(out + off + bj * HALF) = acc[ai][bj][m][0] * rs * g0; *(pg8::f32x4*)(out + off + bj * HALF + 4) = acc[ai][bj][m][1] * rs * g1; }
                asm volatile("" ::: "memory"); }
    }
};

#define PH_BEGIN unsigned char* ws = WSP(); const int G = gridDim.x, bid = blockIdx.x; const int a = layer & 1; \
        b16* xb_a = (b16*)(ws + (a ? WS_XB1 : WS_XB0)); b16* xb_o = (b16*)(ws + (a ? WS_XB0 : WS_XB1)); \
        float* part_a = (float*)(ws + (a ? WS_PART1 : WS_PART0)); float* part_o = (float*)(ws + (a ? WS_PART0 : WS_PART1)); (void)xb_a; (void)xb_o; (void)part_a; (void)part_o; (void)G; (void)bid;
#define TID_NOW() (wave * 64 + pg8::lane_id_now())
template <int layer> __device__ __forceinline__ void run_layer(LAS unsigned char* lds, const int wave, const XcdBarrier& bar) {
    typedef pg8::bf16_t b16;
        if (PHMASK & 2) { PH_BEGIN
            pg8::Gemm g{(const b16*)(ws + WS_PB) + (size_t)layer * M * PLE, (const b16*)(ws + WS_PLEP + (size_t)layer * MiB), M, D, PLE}; pg8::StaticOrder S; S.init(M, D, G, bid);
            pg8::EpiBf16G<0, false, false, 32> E{(b16*)(ws + WS_PROJ), D, nullptr, nullptr, 0};
            pg8::gemm_phase<pg8::EpiBf16G<0, false, false, 32>, pg8::StaticOrder, ALIGN_ON, true>(lds, g, S, E, wave); }
        if (layer == 0) {
            if (PHMASK & 4) { PH_BEGIN
                pg8::Gemm g{xb_a, (const b16*)(ws + WS_GMIN), M, 4096, D}; pg8::StaticOrder S; S.init(M, 4096, G, bid);
                pg8::EpiBf16G<1, true, true, 32> E{(b16*)(ws + WS_H), 4096, part_a, (float*)(ws + WS_VSTAT), 8};
                pg8::gemm_phase<pg8::EpiBf16G<1, true, true, 32>, pg8::StaticOrder, ALIGN_ON, true>(lds, g, S, E, wave); }
            xcd_barrier(bar);
            spatial_phase(lds, TID_NOW(), 0, wave);
            if (REP_SPAT > 1) spatial_phase(lds, TID_NOW(), 0, wave);
            if (REP_SPAT > 2) spatial_phase(lds, TID_NOW(), 0, wave);
            prefetch_b0(lds, (const pg8::bf16_t*)(WSP() + WS_GMOUT), D, D, wave);
            xcd_barrier(bar);
            if (PHMASK & 16) { PH_BEGIN
                pg8::Gemm g{(const b16*)(ws + WS_G), (const b16*)(ws + WS_GMOUT), M, D, D}; pg8::StaticOrder S; S.init(M, D, G, bid);
#if P3_BF16_RES
                pg8::EpiRes<0, 32, false, false> E{nullptr, xb_a, nullptr, xb_o, part_o, nullptr, nullptr};
                pg8::gemm_phase<pg8::EpiRes<0, 32, false, false>, pg8::StaticOrder, ALIGN_ON, true>(lds, g, S, E, wave); }
#else
                pg8::EpiRes<0, 32, true, false> E{INP(I_X), nullptr, nullptr, xb_o, part_o, nullptr, nullptr};
                pg8::gemm_phase<pg8::EpiRes<0, 32, true, false>, pg8::StaticOrder, ALIGN_ON, true>(lds, g, S, E, wave); }
#endif
            prefetch_b0(lds, (const pg8::bf16_t*)(WSP() + WS_FFN13), D, 2 * FF, wave);
            xcd_barrier(bar);
        } else {
            if (PHMASK & 32) { PH_BEGIN
                pg8::Gemm g{xb_a, (const b16*)(ws + WS_S5IN), M, D, D}; pg8::StaticOrder S; S.init(M, D, G, bid);
                pg8::EpiBf16G<0, true, false, 32> E{(b16*)(ws + WS_H), D, part_a, nullptr, 0};
                pg8::gemm_phase<pg8::EpiBf16G<0, true, false, 32>, pg8::StaticOrder, ALIGN_ON, true>(lds, g, S, E, wave); }
            xcd_barrier(bar);
            scan_phase(lds, TID_NOW(), 0, wave);
            if (REP_SCAN > 1) scan_phase(lds, TID_NOW(), 0, wave);
            if (REP_SCAN > 2) scan_phase(lds, TID_NOW(), 0, wave);
#ifdef DBL_BAR
            xcd_barrier(bar);
#endif
            prefetch_b0(lds, (const pg8::bf16_t*)(WSP() + WS_S5OUT), D, 4096, wave);
            xcd_barrier(bar);
            if (PHMASK & 128) { PH_BEGIN
                pg8::Gemm g{(const b16*)(ws + WS_G), (const b16*)(ws + WS_S5OUT), M, 4096, D}; pg8::StaticOrder S; S.init(M, 4096, G, bid);
                pg8::EpiGLURes E{xb_a, xb_o, part_o};
                pg8::gemm_phase<pg8::EpiGLURes, pg8::StaticOrder, ALIGN_ON, true>(lds, g, S, E, wave); }
            prefetch_b0(lds, (const pg8::bf16_t*)(WSP() + WS_FFN13 + (size_t)layer * 44 * MiB), D, 2 * FF, wave);
            xcd_barrier(bar);
        }
        for (int rep = 0; rep < REP_UP; ++rep) { PH_BEGIN
            pg8::Gemm g{xb_o, (const b16*)(ws + WS_FFN13 + (size_t)layer * 44 * MiB), M, 2 * FF, D}; pg8::HalfTailOrder S; S.init(M, 2 * FF, G, bid); S.full_rounds = HALFM_ON ? (M / 256) * (2 * FF / 256) / G : 1000;
            if (layer == 0) { pg8::EpiSwiGLU<32> E{(b16*)(ws + WS_H), FF, part_o}; pg8::gemm_phase<pg8::EpiSwiGLU<32>, pg8::HalfTailOrder, ALIGN_ON, true, HALFM_ON>(lds, g, S, E, wave); }
            else { pg8::EpiSwiGLU<64> E{(b16*)(ws + WS_H), FF, part_o}; pg8::gemm_phase<pg8::EpiSwiGLU<64>, pg8::HalfTailOrder, ALIGN_ON, true, HALFM_ON>(lds, g, S, E, wave); } }
        prefetch_b0(lds, (const pg8::bf16_t*)(WSP() + WS_FFN2 + (size_t)layer * 22 * MiB), FF, D, wave);
        xcd_barrier(bar);
        if (PHMASK & 512) { PH_BEGIN
            pg8::Gemm g{(const b16*)(ws + WS_H), (const b16*)(ws + WS_FFN2 + (size_t)layer * 22 * MiB), M, D, FF}; pg8::StaticOrder S; S.init(M, D, G, bid);
            pg8::EpiRes<0, 32, false, false> E{nullptr, xb_o, nullptr, xb_a, part_a, nullptr, nullptr};
            pg8::gemm_phase<pg8::EpiRes<0, 32, false, false>, pg8::StaticOrder, ALIGN_ON, true>(lds, g, S, E, wave); }
        prefetch_b0(lds, (const pg8::bf16_t*)(WSP() + WS_PLEG + (size_t)layer * 8 * MiB), D, D, wave);
        xcd_barrier(bar);
        if (PHMASK & 1024) { PH_BEGIN
            pg8::Gemm g{xb_a, (const b16*)(ws + WS_PLEG + (size_t)layer * 8 * MiB), M, D, D}; pg8::StaticOrder S; S.init(M, D, G, bid);
            if (layer == 0) { pg8::EpiRes<1, 32, false, false> E{nullptr, xb_a, nullptr, xb_o, part_o, part_a, (const b16*)(ws + WS_PROJ)};
                pg8::gemm_phase<pg8::EpiRes<1, 32, false, false>, pg8::StaticOrder, ALIGN_ON, true>(lds, g, S, E, wave); }
            else { EpiFinal E{xb_a, OUTP(), part_o, part_a, (const b16*)(ws + WS_PROJ), INP(I_NFIN), bar};
                pg8::gemm_phase<EpiFinal, pg8::StaticOrder, false, true>(lds, g, S, E, wave); } }
        if (layer == 0) prefetch_b0(lds, (const pg8::bf16_t*)(WSP() + WS_PLEP + 1 * MiB), PLE, D, wave);
        if (layer == 0) xcd_barrier(bar);
    }

__global__ void __launch_bounds__(512, 2) mk_fwd(Params P) {
    extern __shared__ __attribute__((aligned(16))) unsigned char lds_raw[];
    LAS unsigned char* lds = (LAS unsigned char*)lds_raw;
    cg::grid_group grid = cg::this_grid();
    const int wave = __builtin_amdgcn_readfirstlane(threadIdx.x >> 6);
    typedef pg8::bf16_t b16;
    volatile LAS unsigned* MISC = (volatile LAS unsigned*)(lds + MISC_OFF);
    if (threadIdx.x < 64) MISC[threadIdx.x] = 0u;
    __syncthreads();
    const XcdBarrier bar = xcd_barrier_post((unsigned*)(WSP() + WS_CTL), MISC + 8);

    prologue(lds, TID_NOW(), 0, wave);
    if (REP_PRO > 1) prologue(lds, TID_NOW(), 0, wave);
    if (REP_PRO > 2) prologue(lds, TID_NOW(), 0, wave);
    if (WSP() == nullptr) grid.sync();
    xcd_barrier(bar);
    for (int rep = 0; rep < EXTRA_SYNC; ++rep) xcd_barrier(bar);

    run_layer<0>(lds, wave, bar);
    run_layer<1>(lds, wave, bar);
}

extern "C" void kernel_launch(void* const* d_in, const int* in_sizes, int n_in, void* d_out, int out_size, void* d_ws, size_t ws_size, hipStream_t stream) {
    static int grid = 0;
    if (grid == 0) {
        if (n_in != 27 || in_sizes[0] != M * D || out_size != M * D || ws_size < WS_END) { fprintf(stderr, "kernel_launch: unexpected shapes: n_in %d in0 %d out %d ws %zu (need %zu)\n", n_in, n_in > 0 ? in_sizes[0] : -1, out_size, ws_size, (size_t)WS_END); grid = -1; return; }
        int dev = 0, cus = 0, per_cu = 0;
        if (hipGetDevice(&dev) != hipSuccess || hipDeviceGetAttribute(&cus, hipDeviceAttributeMultiprocessorCount, dev) != hipSuccess) { grid = -1; return; }
        if (hipFuncSetAttribute((const void*)mk_fwd, hipFuncAttributeMaxDynamicSharedMemorySize, LDS_BYTES) != hipSuccess) { fprintf(stderr, "kernel_launch: hipFuncSetAttribute failed\n"); grid = -1; return; }
        if (hipOccupancyMaxActiveBlocksPerMultiprocessor(&per_cu, (const void*)mk_fwd, 512, LDS_BYTES) != hipSuccess || per_cu < 1) { fprintf(stderr, "kernel_launch: occupancy query reports %d workgroups per CU\n", per_cu); (void)hipGetLastError(); grid = -1; return; }
        grid = cus;
    }
    if (grid < 0) return;
    if (hipMemsetAsync((char*)d_ws + WS_CTL, 0, CTL_ZERO_BYTES, stream) != hipSuccess) { fprintf(stderr, "kernel_launch: hipMemsetAsync failed\n"); return; }
    Params p{};
    for (int i = 0; i < 27; ++i) p.in[i] = (const float*)d_in[i];
    p.out = (float*)d_out; p.ws = (unsigned char*)d_ws;
    void* args[] = {&p};
    const hipError_t e = hipLaunchCooperativeKernel((const void*)mk_fwd, dim3(grid), dim3(512), args, LDS_BYTES, stream);
    if (e != hipSuccess) fprintf(stderr, "kernel_launch: cooperative launch failed: %s (grid %d)\n", hipGetErrorString(e), grid);
}
```

```cpp
#include <hip/hip_runtime.h>
#include <hip/hip_cooperative_groups.h>
#include <cstdio>
#include <cstdint>
namespace cg = cooperative_groups;
#define CONV_IN_SCAN 1
#define LATE_SET 50
#define CONV_PLAIN 1
#define CONV_KA 0
#define SEG_B 8
#define P3_BF16_RES 1
namespace pg8 {
#define PG8_LAS __attribute__((address_space(3)))
typedef unsigned short bf16_t;
typedef short bf16x8 __attribute__((ext_vector_type(8)));
typedef float f32x4 __attribute__((ext_vector_type(4)));
typedef unsigned u32x4 __attribute__((ext_vector_type(4)));
constexpr int BM = 256, BK = 64, HALF = 128, HTB = HALF * BK * 2  , STAGE_BYTES = 8 * HTB, NXCD = 8, WGM = 8;

__host__ __device__ __forceinline__ int lds_byte(int r, int c) { const int st = (r >> 4) * 2 + (c >> 5), rr = r & 15, cc = c & 31, ob = rr * 64 + cc * 2; return st * 1024 + (ob ^ (((ob >> 9) & 1) << 5)); }
__host__ __device__ __forceinline__ void stage_rc(int b, int& R, int& C) { const int st = b / 1024, sb = b % 1024, swz = sb ^ (((sb >> 9) & 1) << 5); R = (st >> 1) * 16 + swz / 64; C = (st & 1) * 32 + (swz % 64) / 2; }
__host__ __device__ __forceinline__ int perm32(int rho) { const int n = rho >> 4, i = rho & 15; return 8 * (i >> 2) + 4 * n + (i & 3); }

struct Unit { int pm, pn, half; };
struct Gemm { const bf16_t* A; const bf16_t* Bt; int M, N, K; };

struct StaticOrder {
    int nM, nN, nwg, G, c;
    __host__ __device__ void init(int M, int N, int G_, int c_) { nM = M / BM; nN = N / BM; nwg = nM * nN; G = G_; c = c_; }
    __host__ __device__ bool next(int i, Unit& u) const {
        const long L = (long)i * G + c; if (L >= nwg) return false;
        int wgid = (int)L; { const int q = nwg / NXCD, r = nwg % NXCD, xcd = wgid % NXCD, off = wgid / NXCD; wgid = (xcd < r ? xcd * (q + 1) : r * (q + 1) + (xcd - r) * q) + off; }
        const int nig = WGM * nN, gid = wgid / nig, fm = gid * WGM, gsz = (nM - fm) < WGM ? (nM - fm) : WGM;
        u.pm = fm + ((wgid % nig) % gsz); u.pn = (wgid % nig) / gsz; u.half = 0; return true;
    }
    __device__ __forceinline__ void a_ready(const Unit&) const {}
    __device__ __forceinline__ void done(const Unit&) const {}
};

struct HalfTailOrder : StaticOrder {
    int full_rounds;
    __host__ __device__ bool next(int i, Unit& u) const {
        if (i < full_rounds) { StaticOrder t = *this; return t.StaticOrder::next(i, u); }
        if (i > full_rounds) return false;
        StaticOrder t = *this; t.c = (c >> 1); t.G = 0; const long L = (long)full_rounds * G + (c >> 1); if (L >= nwg) return false;
        t.c = (int)L; const bool ok = t.StaticOrder::next(0, u); u.half = 1 + (c & 1); return ok;
    }
};

__device__ __forceinline__ unsigned cvt_pk_bf16(float lo, float hi) { unsigned r; asm volatile("v_cvt_pk_bf16_f32 %0, %1, %2" : "=v"(r) : "v"(lo), "v"(hi)); return r; }
typedef unsigned u32x2 __attribute__((ext_vector_type(2)));
__device__ __forceinline__ int lane_id_now() { int l; asm volatile("v_mbcnt_lo_u32_b32 %0, -1, 0\n\tv_mbcnt_hi_u32_b32 %0, -1, %0" : "=v"(l)); return l; }
constexpr int DM = 2048;
constexpr float RMS_EPS = 1e-6f;
__device__ __forceinline__ float fast_sigmoid(float x) { return __builtin_amdgcn_rcpf(1.0f + __builtin_amdgcn_exp2f(-1.4426950409f * x)); }
__device__ __forceinline__ float gelu_tanh(float x) { const float u = x * (0.7978845608f + 0.0356774081f * x * x); return x * fast_sigmoid(2.0f * u); }
__device__ __forceinline__ float bf_lo(unsigned w) { return __uint_as_float(w << 16); }
__device__ __forceinline__ float bf_hi(unsigned w) { return __uint_as_float(w & 0xffff0000u); }
template <int NPART> __device__ __forceinline__ float row_rstd(const float* part, int row, int fq) {
    const f32x4* pp = (const f32x4*)(part + (size_t)row * NPART) + fq * (NPART / 16);
    float s = 0.f;
#pragma unroll
    for (int j = 0; j < NPART / 16; ++j) { const f32x4 v = pp[j]; s += (v[0] + v[1]) + (v[2] + v[3]); }
    s += __shfl_xor(s, 16); s += __shfl_xor(s, 32);
    return rsqrtf(s * (1.0f / DM) + RMS_EPS);
}

template <int ACT  , bool RSTD, bool VSTATS, int NPART> struct EpiBf16G {
    static constexpr bool PERM = true, AFTER_DRAIN = false;
    bf16_t* O; int ldc; const float* part; float* vstat; int vs_pn0;
    __device__ __forceinline__ void operator()(const f32x4 (&acc)[2][2][4][2], const Unit& u, int wr, int wc, int fr, int fq) const {
        const int row0 = u.pm * BM + wr * 64 + fr, col0 = u.pn * BM + wc * 32 + 8 * fq;
        const bool dov = VSTATS && (u.pn >= vs_pn0);
#pragma unroll
        for (int ai = 0; ai < 2; ++ai)
#pragma unroll
            for (int m = 0; m < 4; ++m) { const int row = row0 + ai * HALF + m * 16;
                float rs = 1.0f; if (RSTD) rs = row_rstd<NPART>(part, row, fq);
                bf16_t* rowp = O + (size_t)row * ldc + col0; float s1 = 0.f, s2 = 0.f;
#pragma unroll
                for (int bj = 0; bj < 2; ++bj) { f32x4 v0 = acc[ai][bj][m][0] * rs, v1 = acc[ai][bj][m][1] * rs;
                    if (ACT == 1) {
#pragma unroll
                        for (int j = 0; j < 4; ++j) { v0[j] = gelu_tanh(v0[j]); v1[j] = gelu_tanh(v1[j]); } }
                    if (VSTATS) {
#pragma unroll
                        for (int j = 0; j < 4; ++j) { s1 += v0[j] + v1[j]; s2 += v0[j] * v0[j] + v1[j] * v1[j]; } }
                    u32x4 w; w.x = cvt_pk_bf16(v0[0], v0[1]); w.y = cvt_pk_bf16(v0[2], v0[3]); w.z = cvt_pk_bf16(v1[0], v1[1]); w.w = cvt_pk_bf16(v1[2], v1[3]);
                    *(u32x4*)(rowp + bj * HALF) = w; }
                if (VSTATS) { s1 += __shfl_xor(s1, 16); s1 += __shfl_xor(s1, 32); s2 += __shfl_xor(s2, 16); s2 += __shfl_xor(s2, 32);
                    if (dov && fq == 0) { float* vp = vstat + ((size_t)row * 32 + (u.pn - vs_pn0) * 4 + wc) * 2; vp[0] = s1; vp[1] = s2; } }
                asm volatile("" ::: "memory");
            }
    }
};

template <int MODE, int NPART, bool XIN_F32, bool XOUT_F32> struct EpiRes {
    static constexpr bool PERM = true, AFTER_DRAIN = false;
    const float* xin_f; const bf16_t* xin_b; float* xout_f; bf16_t* xout_b; float* part_out; const float* part_in; const bf16_t* proj;
    __device__ __forceinline__ void operator()(const f32x4 (&acc)[2][2][4][2], const Unit& u, int wr, int wc, int fr, int fq) const {
        const int row0 = u.pm * BM + wr * 64 + fr, col0 = u.pn * BM + wc * 32 + 8 * fq;
#pragma unroll
        for (int ai = 0; ai < 2; ++ai)
#pragma unroll
            for (int m = 0; m < 4; ++m) { const int row = row0 + ai * HALF + m * 16;
                float rs = 1.0f; if (MODE == 1) rs = row_rstd<NPART>(part_in, row, fq);
                const size_t off = (size_t)row * DM + col0; float ss = 0.f;
#pragma unroll
                for (int bj = 0; bj < 2; ++bj) { const size_t o = off + bj * HALF;
                    f32x4 x0, x1;
                    if (XIN_F32) { x0 = *(const f32x4*)(xin_f + o); x1 = *(const f32x4*)(xin_f + o + 4); }
                    else { const u32x4 w = *(const u32x4*)(xin_b + o); x0 = (f32x4){bf_lo(w.x), bf_hi(w.x), bf_lo(w.y), bf_hi(w.y)}; x1 = (f32x4){bf_lo(w.z), bf_hi(w.z), bf_lo(w.w), bf_hi(w.w)}; }
                    f32x4 a0 = acc[ai][bj][m][0], a1 = acc[ai][bj][m][1];
                    if (MODE == 1) { const u32x4 p = *(const u32x4*)(proj + o);
                        a0[0] = fast_sigmoid(a0[0] * rs) * bf_lo(p.x); a0[1] = fast_sigmoid(a0[1] * rs) * bf_hi(p.x); a0[2] = fast_sigmoid(a0[2] * rs) * bf_lo(p.y); a0[3] = fast_sigmoid(a0[3] * rs) * bf_hi(p.y);
                        a1[0] = fast_sigmoid(a1[0] * rs) * bf_lo(p.z); a1[1] = fast_sigmoid(a1[1] * rs) * bf_hi(p.z); a1[2] = fast_sigmoid(a1[2] * rs) * bf_lo(p.w); a1[3] = fast_sigmoid(a1[3] * rs) * bf_hi(p.w); }
                    const f32x4 n0 = x0 + a0, n1 = x1 + a1;
                    if (XOUT_F32) { *(f32x4*)(xout_f + o) = n0; *(f32x4*)(xout_f + o + 4) = n1; }
                    else { u32x4 w; w.x = cvt_pk_bf16(n0[0], n0[1]); w.y = cvt_pk_bf16(n0[2], n0[3]); w.z = cvt_pk_bf16(n1[0], n1[1]); w.w = cvt_pk_bf16(n1[2], n1[3]); *(u32x4*)(xout_b + o) = w; }
                    ss += ((n0[0] * n0[0] + n0[1] * n0[1]) + (n0[2] * n0[2] + n0[3] * n0[3])) + ((n1[0] * n1[0] + n1[1] * n1[1]) + (n1[2] * n1[2] + n1[3] * n1[3])); }
                ss += __shfl_xor(ss, 16); ss += __shfl_xor(ss, 32);
                if (!XOUT_F32 && fq == 0) part_out[(size_t)row * 32 + u.pn * 4 + wc] = ss;
                asm volatile("" ::: "memory"); }
    }
};

template <int NPART> struct EpiSwiGLU {
    static constexpr bool PERM = true, AFTER_DRAIN = false;
    bf16_t* O; int ldc; const float* part;
    __device__ __forceinline__ void operator()(const f32x4 (&acc)[2][2][4][2], const Unit& u, int wr, int wc, int fr, int fq) const {
        const int row0 = u.pm * BM + (u.half == 2 ? HALF : 0) + wr * 64 + fr, col0 = u.pn * HALF + wc * 32 + 8 * fq;
#pragma unroll
        for (int ai = 0; ai < 2; ++ai) { if (ai == 1 && u.half != 0) break;
#pragma unroll
            for (int m = 0; m < 4; ++m) { const int row = row0 + ai * HALF + m * 16;
                const float rs = row_rstd<NPART>(part, row, fq);
                float h[8];
#pragma unroll
                for (int n = 0; n < 2; ++n)
#pragma unroll
                    for (int j = 0; j < 4; ++j) { const float a1 = acc[ai][0][m][n][j] * rs, a3 = acc[ai][1][m][n][j] * rs; h[n * 4 + j] = a1 * fast_sigmoid(a1) * a3; }
                u32x4 w; w.x = cvt_pk_bf16(h[0], h[1]); w.y = cvt_pk_bf16(h[2], h[3]); w.z = cvt_pk_bf16(h[4], h[5]); w.w = cvt_pk_bf16(h[6], h[7]);
                *(u32x4*)(O + (size_t)row * ldc + col0) = w; asm volatile("" ::: "memory"); } }
    }
};

struct EpiGLURes {
    static constexpr bool PERM = true, AFTER_DRAIN = false;
    const bf16_t* xin_b; bf16_t* xout_b; float* part_out;
    __device__ __forceinline__ void operator()(const f32x4 (&acc)[2][2][4][2], const Unit& u, int wr, int wc, int fr, int fq) const {
        const int row0 = u.pm * BM + wr * 64 + fr, col0 = u.pn * HALF + wc * 32 + 8 * fq;
#pragma unroll
        for (int ai = 0; ai < 2; ++ai)
#pragma unroll
            for (int m = 0; m < 4; ++m) { const int row = row0 + ai * HALF + m * 16;
                const size_t o = (size_t)row * DM + col0; float ss = 0.f;
                const u32x4 xw = *(const u32x4*)(xin_b + o); const float xo[8] = {bf_lo(xw.x), bf_hi(xw.x), bf_lo(xw.y), bf_hi(xw.y), bf_lo(xw.z), bf_hi(xw.z), bf_lo(xw.w), bf_hi(xw.w)};
                float xn[8];
#pragma unroll
                for (int n = 0; n < 2; ++n)
#pragma unroll
                    for (int j = 0; j < 4; ++j) { xn[n * 4 + j] = xo[n * 4 + j] + acc[ai][0][m][n][j] * fast_sigmoid(acc[ai][1][m][n][j]); ss += xn[n * 4 + j] * xn[n * 4 + j]; }
                u32x4 w; w.x = cvt_pk_bf16(xn[0], xn[1]); w.y = cvt_pk_bf16(xn[2], xn[3]); w.z = cvt_pk_bf16(xn[4], xn[5]); w.w = cvt_pk_bf16(xn[6], xn[7]); *(u32x4*)(xout_b + o) = w;
                ss += __shfl_xor(ss, 16); ss += __shfl_xor(ss, 32);
                if (fq == 0) part_out[(size_t)row * 64 + u.pn * 4 + wc] = ss;
                asm volatile("" ::: "memory"); }
    }
};

template <class Epi, class Sched, bool ALIGN_EPI = false, bool SP2 = false, bool HALFM = false>
__device__ __forceinline__ void gemm_phase(PG8_LAS unsigned char* lds, const Gemm g, const Sched& S, const Epi& E, const int wave_sgpr) {
    int tid_ = wave_sgpr * 64 + lane_id_now(); asm volatile("" : "+v"(tid_));
    const int tid = tid_, wid = __builtin_amdgcn_readfirstlane(tid >> 6), lane = tid & 63, wr = wid >> 2, wc = wid & 3, fr = lane & 15, fq = lane >> 4;
    const int K = g.K, nt = K / BK;
    unsigned voffA[2], voffB[2];
#pragma unroll
    for (int i = 0; i < 2; ++i) { int R, C; stage_rc(tid * 16 + i * 8192, R, C); const int Rb = Epi::PERM ? ((R & ~31) + perm32(R & 31)) : R;
        voffA[i] = (unsigned)(R * K + C) * 2u; voffB[i] = (unsigned)(Rb * K + C) * 2u; }
    const size_t kstep = (size_t)(BK * 2);
    const size_t hstep = (size_t)HALF * K * 2;
    const size_t tstep = 2 * hstep;
    const unsigned ldsw = (unsigned)wid * 1024u;
    const int aoff = lds_byte(wr * 64 + fr, fq * 8), boff = lds_byte(wc * 32 + fr, fq * 8);
#define PG8_SA(b, h) (((b) * 2 + (h)) * HTB)
#define PG8_SB(b, h) ((4 + (b) * 2 + (h)) * HTB)
#define PG8_STAGE(bufoff, gbase, voff) do { _Pragma("unroll") for (int _i = 0; _i < 2; ++_i) \
        __builtin_amdgcn_global_load_lds((const unsigned*)((const char*)(gbase) + (voff)[_i]), (PG8_LAS unsigned*)(lds + (bufoff) + ldsw + _i * 8192), 16, 0, 0); } while (0)
#define PG8_LDA(dst, b, h) do { _Pragma("unroll") for (int m = 0; m < 4; ++m) _Pragma("unroll") for (int k = 0; k < 2; ++k) dst[m][k] = *(const PG8_LAS bf16x8*)(lds + PG8_SA(b, h) + aoff + m * 2048 + k * 1024); } while (0)
#define PG8_LDB(dst, b, h) do { _Pragma("unroll") for (int n = 0; n < 2; ++n) _Pragma("unroll") for (int k = 0; k < 2; ++k) dst[n][k] = *(const PG8_LAS bf16x8*)(lds + PG8_SB(b, h) + boff + n * 2048 + k * 1024); } while (0)
#define PG8_MMA(ai, bj, At, Bt) do { __builtin_amdgcn_s_setprio(1); _Pragma("unroll") for (int m = 0; m < 4; ++m) _Pragma("unroll") for (int n = 0; n < 2; ++n) _Pragma("unroll") for (int k = 0; k < 2; ++k) \
        acc[ai][bj][m][n] = __builtin_amdgcn_mfma_f32_16x16x32_bf16(Bt[n][k], At[m][k], acc[ai][bj][m][n], 0, 0, 0); __builtin_amdgcn_s_setprio(0); } while (0)
#define PG8_WAIT_V(n) asm volatile("s_waitcnt vmcnt(" #n ")" ::: "memory")
#define PG8_WAIT_L(n) asm volatile("s_waitcnt lgkmcnt(" #n ")" ::: "memory")
#define PG8_BAR __builtin_amdgcn_s_barrier()
#define PG8_SCHED __builtin_amdgcn_sched_barrier(0)
    Unit cur, nxt; int ui = 0;
    if (!S.next(0, cur)) return;
    f32x4 acc[2][2][4][2];
#pragma unroll
    for (int a = 0; a < 2; ++a)
#pragma unroll
        for (int b = 0; b < 2; ++b)
#pragma unroll
            for (int m = 0; m < 4; ++m)
#pragma unroll
                for (int n = 0; n < 2; ++n) acc[a][b][m][n] = (f32x4){0.f, 0.f, 0.f, 0.f};
    bf16x8 At[4][2], B0[2][2], B1[2][2];
    const char* cA = (const char*)g.A + (size_t)cur.pm * tstep + ((HALFM && cur.half == 2) ? hstep : 0); const char* cB = (const char*)g.Bt + (size_t)cur.pn * tstep;
    S.a_ready(cur);
    if constexpr (SP2) {
        PG8_STAGE(PG8_SB(0, 0), cB, voffB); PG8_STAGE(PG8_SB(0, 1), cB + hstep, voffB); PG8_STAGE(PG8_SA(0, 0), cA, voffA); PG8_STAGE(PG8_SA(0, 1), cA + hstep, voffA);
        if (wr == 1) PG8_BAR;
        PG8_WAIT_V(2); PG8_BAR;
        PG8_STAGE(PG8_SB(1, 0), cB + kstep, voffB); PG8_STAGE(PG8_SA(1, 0), cA + kstep, voffA); PG8_STAGE(PG8_SB(1, 1), cB + hstep + kstep, voffB);
        PG8_WAIT_V(6); PG8_BAR;
    } else {
        PG8_STAGE(PG8_SB(0, 0), cB, voffB); PG8_STAGE(PG8_SA(0, 0), cA, voffA); PG8_STAGE(PG8_SB(0, 1), cB + hstep, voffB); PG8_STAGE(PG8_SA(0, 1), cA + hstep, voffA);
        if (wr == 1) PG8_BAR;
        PG8_WAIT_V(4); PG8_BAR;
        PG8_STAGE(PG8_SB(1, 0), cB + kstep, voffB); PG8_STAGE(PG8_SA(1, 0), cA + kstep, voffA); PG8_STAGE(PG8_SB(1, 1), cB + hstep + kstep, voffB);
        PG8_WAIT_V(6); PG8_BAR;
    }
    for (;;) {
        const bool has_next = S.next(ui + 1, nxt);
        const char* nA = has_next ? (const char*)g.A + (size_t)nxt.pm * tstep + ((HALFM && nxt.half == 2) ? hstep : 0) : cA; const char* nB = has_next ? (const char*)g.Bt + (size_t)nxt.pn * tstep : cB;
        for (int t = 0; t < nt; t += 2) {
            const bool last = (t == nt - 2);
            const char* a1 = cA + (size_t)(t + 1) * kstep;
            const char* a2 = last ? nA : cA + (size_t)(t + 2) * kstep; const char* b2 = last ? nB : cB + (size_t)(t + 2) * kstep;
            const char* a3 = a2 + kstep; const char* b3 = b2 + kstep;
            if (last && has_next) S.a_ready(nxt);
            if constexpr (SP2) {
            PG8_LDB(B0, 0, 0); PG8_LDB(B1, 0, 1); PG8_SCHED; PG8_LDA(At, 0, 0); PG8_STAGE(PG8_SA(1, 1), a1 + hstep, voffA);
            PG8_WAIT_V(8); PG8_WAIT_L(0); PG8_BAR; PG8_MMA(0, 0, At, B0); PG8_MMA(0, 1, At, B1); PG8_BAR; PG8_SCHED;
            PG8_LDA(At, 0, 1); PG8_STAGE(PG8_SB(0, 0), b2, voffB); PG8_STAGE(PG8_SB(0, 1), b2 + hstep, voffB); PG8_STAGE(PG8_SA(0, 0), a2, voffA);
            PG8_WAIT_V(8); PG8_WAIT_L(0); PG8_BAR; if (!HALFM || cur.half == 0) { PG8_MMA(1, 0, At, B0); PG8_MMA(1, 1, At, B1); } PG8_BAR; PG8_SCHED;
            PG8_LDB(B0, 1, 0); PG8_LDB(B1, 1, 1); PG8_SCHED; PG8_LDA(At, 1, 0); PG8_STAGE(PG8_SA(0, 1), a2 + hstep, voffA);
            PG8_WAIT_V(8); PG8_WAIT_L(0); PG8_BAR; PG8_MMA(0, 0, At, B0); PG8_MMA(0, 1, At, B1); PG8_BAR; PG8_SCHED;
            PG8_LDA(At, 1, 1); PG8_STAGE(PG8_SB(1, 0), b3, voffB); PG8_STAGE(PG8_SB(1, 1), b3 + hstep, voffB); PG8_STAGE(PG8_SA(1, 0), a3, voffA);
            PG8_WAIT_V(8); PG8_WAIT_L(0); PG8_BAR; if (!HALFM || cur.half == 0) { PG8_MMA(1, 0, At, B0); PG8_MMA(1, 1, At, B1); } PG8_BAR; PG8_SCHED;
            } else {
            PG8_LDB(B0, 0, 0); PG8_SCHED; PG8_LDA(At, 0, 0); PG8_STAGE(PG8_SA(1, 1), a1 + hstep, voffA);
            PG8_WAIT_L(8); PG8_BAR; PG8_WAIT_L(0); PG8_MMA(0, 0, At, B0); PG8_BAR; PG8_SCHED;
            PG8_LDB(B1, 0, 1); PG8_STAGE(PG8_SB(0, 0), b2, voffB);
            PG8_BAR; PG8_WAIT_L(0); PG8_MMA(0, 1, At, B1); PG8_BAR;
            PG8_LDA(At, 0, 1); PG8_STAGE(PG8_SA(0, 0), a2, voffA);
            PG8_BAR; PG8_WAIT_L(0); PG8_MMA(1, 0, At, B0); PG8_BAR; PG8_SCHED;
            PG8_STAGE(PG8_SB(0, 1), b2 + hstep, voffB);
            PG8_WAIT_V(6); PG8_BAR; PG8_MMA(1, 1, At, B1); PG8_BAR;
            PG8_LDB(B0, 1, 0); PG8_SCHED; PG8_LDA(At, 1, 0); PG8_STAGE(PG8_SA(0, 1), a2 + hstep, voffA);
            PG8_WAIT_L(8); PG8_BAR; PG8_WAIT_L(0); PG8_MMA(0, 0, At, B0); PG8_BAR; PG8_SCHED;
            PG8_LDB(B1, 1, 1); PG8_STAGE(PG8_SB(1, 0), b3, voffB);
            PG8_BAR; PG8_WAIT_L(0); PG8_MMA(0, 1, At, B1); PG8_BAR;
            PG8_LDA(At, 1, 1); PG8_STAGE(PG8_SA(1, 0), a3, voffA);
            PG8_BAR; PG8_WAIT_L(0); PG8_MMA(1, 0, At, B0); PG8_BAR; PG8_SCHED;
            PG8_STAGE(PG8_SB(1, 1), b3 + hstep, voffB);
            PG8_WAIT_V(6); PG8_BAR; PG8_MMA(1, 1, At, B1); PG8_BAR;
            }
        }
        if constexpr (ALIGN_EPI) { if (wr == 0) PG8_BAR; }
        if constexpr (!Epi::AFTER_DRAIN) { E(acc, cur, wr, wc, fr, fq); S.done(cur); }
        if (!has_next) break;
#pragma unroll
        for (int a = 0; a < 2; ++a)
#pragma unroll
            for (int b = 0; b < 2; ++b)
#pragma unroll
                for (int m = 0; m < 4; ++m)
#pragma unroll
                    for (int n = 0; n < 2; ++n) acc[a][b][m][n] = (f32x4){0.f, 0.f, 0.f, 0.f};
        cur = nxt; cA = nA; cB = nB; ++ui;
        if constexpr (ALIGN_EPI) { if (wr == 1) PG8_BAR; }
    }
    PG8_WAIT_V(0);
    if constexpr (!ALIGN_EPI) { if (wr == 0) PG8_BAR; }
    PG8_BAR;
    if constexpr (Epi::AFTER_DRAIN) { E.fused(acc, cur, wr, wc, fr, fq, lds, wid, lane); S.done(cur); }
#undef PG8_SA
#undef PG8_SB
#undef PG8_STAGE
#undef PG8_LDA
#undef PG8_LDB
#undef PG8_MMA
#undef PG8_WAIT_V
#undef PG8_WAIT_L
#undef PG8_BAR
#undef PG8_SCHED
}
}

constexpr int M = 8192, D = 2048, SEQ = 2048, NB = 4, FF = 5632, PLE = 256, GW = 2048, CHUNK = 128, HEADS = 16, S5G = 128, S5P = 64, S5C = 16;
constexpr float EPS = 1e-6f;
constexpr size_t MiB = 1u << 20;
constexpr size_t WS_PART0 = 0, WS_PART1 = 2 * MiB, WS_VSTAT = 4 * MiB, WS_WC = 6 * MiB, WS_PB = 8 * MiB;
constexpr size_t WS_GMIN = 16 * MiB, WS_GMOUT = 32 * MiB, WS_S5IN = 40 * MiB, WS_S5OUT = 48 * MiB, WS_FFN13 = 64 * MiB  , WS_FFN2 = 152 * MiB  , WS_PLEG = 196 * MiB  , WS_PLEP = 212 * MiB  ;
constexpr size_t WS_XB0 = 216 * MiB, WS_XB1 = 248 * MiB, WS_H = 280 * MiB  , WS_G = 368 * MiB, WS_PROJ = 400 * MiB, WS_CTL = 432 * MiB  , WS_END = 433 * MiB;
constexpr size_t CTL_ZERO_BYTES = 16384;
#ifndef PHMASK
#define PHMASK 4095
#endif
#ifndef LATE_SCRATCH
#define LATE_SCRATCH 0
#endif
#ifndef CONV_KA
#define CONV_KA 3
#endif
#ifndef SEG_B
#define SEG_B 8
#endif
#ifndef P3_BF16_RES
#define P3_BF16_RES 0
#endif
#ifndef CONV_PLAIN
#define CONV_PLAIN 0
#endif
#ifndef CONV_IMMEDIATE
#define CONV_IMMEDIATE 0
#endif
#ifndef DUP_PRO
#define DUP_PRO 0
#endif
#ifndef LATE_SET
#define LATE_SET 63
#endif
#ifndef CONV_IN_SCAN
#define CONV_IN_SCAN 0
#endif
#ifndef XB_SLEEP
#define XB_SLEEP 8
#endif
#ifndef PFB_ON
#define PFB_ON 0
#endif
#ifndef ALIGN_ON
#define ALIGN_ON true
#endif
#ifndef HALFM_ON
#define HALFM_ON true
#endif
#ifndef REP_PRO
#define REP_PRO 1
#endif
#ifndef REP_SCAN
#define REP_SCAN 1
#endif
#ifndef REP_SPAT
#define REP_SPAT 1
#endif
#ifndef REP_UP
#define REP_UP 1
#endif
#ifndef EXTRA_SYNC
#define EXTRA_SYNC 0
#endif
constexpr int MISC_OFF = 8 * 16640 + 4096, LDS_BYTES = MISC_OFF + 1024;

#define LAS __attribute__((address_space(3)))
typedef unsigned short bf16;
typedef unsigned v4u __attribute__((ext_vector_type(4)));
typedef unsigned v2u __attribute__((ext_vector_type(2)));
typedef float f32x4 __attribute__((ext_vector_type(4)));
typedef short bf16x8 __attribute__((ext_vector_type(8)));
#define LDS_WAIT() asm volatile("s_waitcnt lgkmcnt(0)" ::: "memory")
using pg8::cvt_pk_bf16; using pg8::bf_lo; using pg8::bf_hi; using pg8::gelu_tanh;

struct Params { const float* in[27]; float* out; unsigned char* ws; };
enum { I_X = 0, I_P, I_NMIX, I_NFFN, I_NPLE, I_NFIN, I_GMIN, I_LNG, I_LNB, I_WS, I_BS, I_GMOUT, I_S5IN, I_ARE, I_AIM, I_LOGDT, I_BRE, I_BIM, I_CRE, I_CIM, I_S5D, I_S5OUT, I_W1, I_W3, I_W2, I_PLEG, I_PLEP };


typedef __attribute__((address_space(4))) const unsigned char* kaptr_t;
__device__ __forceinline__ kaptr_t ka_base() { kaptr_t p = (kaptr_t)__builtin_amdgcn_kernarg_segment_ptr(); asm volatile("" : "+s"(p)); return p; }
#define INP(i) (*(const float* const __attribute__((address_space(4)))*)(ka_base() + 8 * (i)))
#define OUTP() (*(float* const __attribute__((address_space(4)))*)(ka_base() + 8 * 27))
#define WSP() (*(unsigned char* const __attribute__((address_space(4)))*)(ka_base() + 8 * 28))

__device__ __forceinline__ float wave_sum(float v) {
#pragma unroll
    for (int o = 1; o < 64; o <<= 1) v += __shfl_xor(v, o);
    return v;
}

__device__ __forceinline__ void tr_issue(const float* W, int ldn, int nblk, int item, int lane, f32x4 (&v)[16]) {
    const int kb = item / nblk, nb = item - kb * nblk, k0 = 64 * kb, n0 = 64 * nb;
    const int r = lane >> 4, q = lane & 15;
    const float* src = W + (size_t)(k0 + 2 * r) * ldn + n0 + 4 * q;
#pragma unroll
    for (int i = 0; i < 16; ++i) v[i] = *(const f32x4*)(src + (size_t)(8 * (i >> 1) + (i & 1)) * ldn);
}
__device__ __forceinline__ void tr_finish(int K, int nblk, const float* ks, bf16* WT, int mode, LAS unsigned* scr, int item, int lane, f32x4 (&v)[16]) {
    const int kb = item / nblk, nb = item - kb * nblk, k0 = 64 * kb, n0 = 64 * nb;
    const int r = lane >> 4, q = lane & 15;
    if (ks) {
#pragma unroll
        for (int ip = 0; ip < 8; ++ip) { const float s0 = ks[k0 + 8 * ip + 2 * r], s1 = ks[k0 + 8 * ip + 2 * r + 1]; v[2 * ip] *= s0; v[2 * ip + 1] *= s1; } }
#pragma unroll
    for (int ip = 0; ip < 8; ++ip) { v4u w; w.x = cvt_pk_bf16(v[2 * ip][0], v[2 * ip + 1][0]); w.y = cvt_pk_bf16(v[2 * ip][1], v[2 * ip + 1][1]); w.z = cvt_pk_bf16(v[2 * ip][2], v[2 * ip + 1][2]); w.w = cvt_pk_bf16(v[2 * ip][3], v[2 * ip + 1][3]);
        *(LAS v4u*)(scr + (4 * ip + r) * 68 + 4 * q) = w; }
    LDS_WAIT();
    const int c = lane & 7, ngl = lane >> 3;
    const int r0 = (mode == 0) ? n0 : ((n0 >> 7) * 256 + (n0 & 127) + (mode == 2 ? 128 : 0));
#pragma unroll
    for (int rd = 0; rd < 2; ++rd) { const int ng = ngl + 8 * rd; v4u m[4];
#pragma unroll
        for (int j = 0; j < 4; ++j) m[j] = *(const LAS v4u*)(scr + (4 * c + j) * 68 + 4 * ng);
#pragma unroll
        for (int i = 0; i < 4; ++i) { v4u o; o.x = m[0][i]; o.y = m[1][i]; o.z = m[2][i]; o.w = m[3][i]; *(v4u*)(WT + (size_t)(r0 + 4 * ng + i) * K + k0 + 8 * c) = o; } }
    LDS_WAIT();
}
__device__ __forceinline__ void tr_item(const float* W, int K, int ldn, int nblk, const float* ks, bf16* WT, int mode, LAS unsigned* scr, int item, int lane) {
    f32x4 v[16]; tr_issue(W, ldn, nblk, item, lane, v); tr_finish(K, nblk, ks, WT, mode, scr, item, lane, v);
}
constexpr int L1C_B = 32 * 32, L1C_F = 32 * 88, L1C_2 = 88 * 32;
constexpr int LN0 = (LATE_SET & 1) ? L1C_B : 0, LN1 = (LATE_SET & 2) ? L1C_B : 0, LN2 = (LATE_SET & 4) ? L1C_F : 0, LN3 = (LATE_SET & 8) ? L1C_F : 0, LN4 = (LATE_SET & 16) ? L1C_2 : 0, LN5 = (LATE_SET & 32) ? L1C_B : 0, L1_NIT = LN0 + LN1 + LN2 + LN3 + LN4 + LN5;
struct TrD { const float* W; const float* ks; bf16* WT; int K, ldn, nblk, mode, item; };
__device__ __forceinline__ TrD l1_desc(int it, unsigned char* ws) {
    TrD d; int r = it;
#define TD(cnt, W_, K_, LDN_, NBLK_, KS_, DST_, MODE_) if (r < (cnt)) { d.W = W_; d.K = K_; d.ldn = LDN_; d.nblk = NBLK_; d.ks = KS_; d.WT = (bf16*)(ws + (DST_)); d.mode = MODE_; d.item = r; return d; } r -= (cnt);
    TD(LN0, INP(I_S5OUT), D, 4096, 32, nullptr, WS_S5OUT, 1)
    TD(LN1, INP(I_S5OUT) + 2048, D, 4096, 32, nullptr, WS_S5OUT, 2)
    TD(LN2, INP(I_W1) + (size_t)D * FF, D, FF, 88, INP(I_NFFN) + D, WS_FFN13 + 44 * MiB, 1)
    TD(LN3, INP(I_W3) + (size_t)D * FF, D, FF, 88, INP(I_NFFN) + D, WS_FFN13 + 44 * MiB, 2)
    TD(LN4, INP(I_W2) + (size_t)D * FF, FF, D, 32, nullptr, WS_FFN2 + 22 * MiB, 0)
#undef TD
    d.W = INP(I_PLEG) + (size_t)D * D; d.K = D; d.ldn = D; d.nblk = 32; d.ks = INP(I_NPLE) + D; d.WT = (bf16*)(ws + (LATE_SCRATCH ? (size_t)440 * MiB : WS_PLEG + 8 * MiB)); d.mode = 0; d.item = r; return d;
}

__device__ __forceinline__ void prologue(LAS unsigned char* lds, int tid_in, int lane_in, int wave) {
    int tid = tid_in; asm volatile("" : "+v"(tid)); const int lane = tid & 63; (void)lane_in;
    unsigned char* ws = WSP();
    LAS unsigned* scr = (LAS unsigned*)(lds + wave * 16384);
    const int gw = blockIdx.x * 8 + wave, NGW = gridDim.x * 8;
    constexpr int C_A = 32 * 64, C_B = 32 * 32, C_F = 32 * 88, C_2 = 88 * 32, C_P = 4 * 32;
    constexpr int LS = CONV_IN_SCAN ? LATE_SET : 0;
    constexpr int PN0 = (LS & 1) ? 0 : C_B, PN1 = (LS & 2) ? 0 : C_B, PN2 = (LS & 4) ? 0 : C_F, PN3 = (LS & 8) ? 0 : C_F, PN4 = (LS & 16) ? 0 : C_2, PN5 = ((LS & 32) && !DUP_PRO) ? 0 : C_B;
    constexpr int NITEMS = C_A + 2 * C_F + 2 * C_P + 3 * C_B + C_2 + PN0 + PN1 + PN2 + PN3 + PN4 + PN5;
    for (int it = gw; it < NITEMS; it += NGW) {
        int r = it;
#define TR(cnt, W, K, LDN, NBLK, KS, DST, MODE) if (r < (cnt)) { tr_item(W, K, LDN, NBLK, KS, (bf16*)(ws + (DST)), MODE, scr, r, lane); continue; } r -= (cnt);
        TR(C_A, INP(I_GMIN), D, 4096, 64, INP(I_NMIX), WS_GMIN, 0)
        TR(C_P, INP(I_PLEP), PLE, D, 32, nullptr, WS_PLEP, 0)
        TR(C_F, INP(I_W1), D, FF, 88, INP(I_NFFN), WS_FFN13, 1)
        TR(C_F, INP(I_W3), D, FF, 88, INP(I_NFFN), WS_FFN13, 2)
        TR(C_B, INP(I_GMOUT), D, D, 32, nullptr, WS_GMOUT, 0)
        TR(C_2, INP(I_W2), FF, D, 32, nullptr, WS_FFN2, 0)
        TR(C_B, INP(I_PLEG), D, D, 32, INP(I_NPLE), WS_PLEG, 0)
        TR(C_B, INP(I_S5IN), D, D, 32, INP(I_NMIX) + D, WS_S5IN, 0)
        TR(C_P, INP(I_PLEP) + (size_t)PLE * D, PLE, D, 32, nullptr, WS_PLEP + 1 * MiB, 0)
        TR(PN0, INP(I_S5OUT), D, 4096, 32, nullptr, WS_S5OUT, 1)
        TR(PN1, INP(I_S5OUT) + 2048, D, 4096, 32, nullptr, WS_S5OUT, 2)
        TR(PN2, INP(I_W1) + (size_t)D * FF, D, FF, 88, INP(I_NFFN) + D, WS_FFN13 + 44 * MiB, 1)
        TR(PN3, INP(I_W3) + (size_t)D * FF, D, FF, 88, INP(I_NFFN) + D, WS_FFN13 + 44 * MiB, 2)
        TR(PN4, INP(I_W2) + (size_t)D * FF, FF, D, 32, nullptr, WS_FFN2 + 22 * MiB, 0)
        TR(PN5, INP(I_PLEG) + (size_t)D * D, D, D, 32, INP(I_NPLE) + D, WS_PLEG + 8 * MiB, 0)
    }
    {   const float* x = INP(I_X); bf16* xb = (bf16*)(ws + WS_XB0); float* part = (float*)(ws + WS_PART0);
        for (int m = gw; m < M; m += NGW) {
            const f32x4* xr = (const f32x4*)(x + (size_t)m * D) + lane; v2u* o = (v2u*)(xb + (size_t)m * D) + lane; float s = 0.f;
#pragma unroll
            for (int j = 0; j < 8; ++j) { const f32x4 v = xr[64 * j]; s += (v[0] * v[0] + v[1] * v[1]) + (v[2] * v[2] + v[3] * v[3]); v2u w; w.x = cvt_pk_bf16(v[0], v[1]); w.y = cvt_pk_bf16(v[2], v[3]); o[64 * j] = w; }
            s = wave_sum(s);
            if (lane < 32) part[(size_t)m * 32 + lane] = (lane == 0) ? s : 0.f;
        } }
    {   const f32x4* p4 = (const f32x4*)INP(I_P); v2u* o = (v2u*)(ws + WS_PB); const int n4 = 2 * M * PLE / 4;
        for (int i = blockIdx.x * 512 + tid; i < n4; i += gridDim.x * 512) { const f32x4 v = p4[i]; v2u w; w.x = cvt_pk_bf16(v[0], v[1]); w.y = cvt_pk_bf16(v[2], v[3]); o[i] = w; } }
    {   const float* w = INP(I_WS); bf16* o = (bf16*)(ws + WS_WC);
        for (int i = blockIdx.x * 512 + tid; i < HEADS * CHUNK * CHUNK; i += gridDim.x * 512) { const int s = i & 127, t = (i >> 7) & 127; const float v = (s <= t) ? w[i] : 0.f; o[i] = (bf16)(cvt_pk_bf16(v, v) & 0xffffu); } }
}

__device__ __forceinline__ void spatial_phase(LAS unsigned char* lds, int tid_in, int lane_in, int wave) {
    int tid = tid_in; asm volatile("" : "+v"(tid)); const int lane = tid & 63; (void)lane_in;
    unsigned char* ws = WSP();
    const bf16* zb = (const bf16*)(ws + WS_H); bf16* gb = (bf16*)(ws + WS_G); const bf16* wc = (const bf16*)(ws + WS_WC); const float* vstat = (const float*)(ws + WS_VSTAT);
    const float* lng = INP(I_LNG); const float* lnb = INP(I_LNB); const float* bs = INP(I_BS);
    constexpr int VP = 136;
    LAS bf16* VT = (LAS bf16*)lds; LAS float* ST = (LAS float*)(lds + 128 * VP * 2);
    const int s = tid & 127, q4 = tid >> 7, r = lane & 15, kq = lane >> 4, G = gridDim.x;
    v4u vw[4];
    const int PER = (64 * HEADS) / G, ubase = (PER >= 1 && PER <= 16 && (16 % PER) == 0 && PER * G == 64 * HEADS) ? (int)blockIdx.x * PER : -1;
    {   const int unit = (ubase >= 0) ? ubase : (int)blockIdx.x; if (unit < 64 * HEADS) { const bf16* vp = zb + (size_t)((unit >> 4) * CHUNK + s) * 4096 + GW + (unit & 15) * 128 + q4 * 32;
#pragma unroll
            for (int c = 0; c < 4; ++c) vw[c] = *(const v4u*)(vp + 8 * c); } }
    const int ustep = (ubase >= 0) ? 1 : G, uend = (ubase >= 0) ? ubase + PER : 64 * HEADS;
    for (int unit = (ubase >= 0) ? ubase : (int)blockIdx.x; unit < uend; unit += ustep) {
        const int h = unit & 15, tok0 = (unit >> 4) * CHUNK;
        v2u uw[8];
        {   const int tokq = tok0 + 16 * wave + r;
#pragma unroll
            for (int dt = 0; dt < 8; ++dt) uw[dt] = *(const v2u*)(zb + (size_t)tokq * 4096 + h * 128 + dt * 16 + 4 * kq); }
        if (tid < 128 && (ubase < 0 || unit == ubase)) { const f32x4* sp = (const f32x4*)(vstat + (size_t)(tok0 + tid) * 64); float s1 = 0.f, s2 = 0.f;
#pragma unroll
            for (int j = 0; j < 16; ++j) { const f32x4 v = sp[j]; s1 += v[0] + v[2]; s2 += v[1] + v[3]; }
            const float mean = s1 * (1.0f / GW), var = s2 * (1.0f / GW) - mean * mean; ST[2 * tid] = mean; ST[2 * tid + 1] = rsqrtf(var + EPS); }
        __syncthreads();
        {   const float mean = ST[2 * s], rstd = ST[2 * s + 1];
#pragma unroll
            for (int c = 0; c < 4; ++c) { const v4u w = vw[c]; const int d0 = q4 * 32 + 8 * c;
                const f32x4 g0 = *(const f32x4*)(lng + h * 128 + d0), g1 = *(const f32x4*)(lng + h * 128 + d0 + 4), b0 = *(const f32x4*)(lnb + h * 128 + d0), b1 = *(const f32x4*)(lnb + h * 128 + d0 + 4);
                float v[8] = {bf_lo(w.x), bf_hi(w.x), bf_lo(w.y), bf_hi(w.y), bf_lo(w.z), bf_hi(w.z), bf_lo(w.w), bf_hi(w.w)};
#pragma unroll
                for (int j = 0; j < 8; ++j) { const float g = j < 4 ? g0[j & 3] : g1[j & 3], b = j < 4 ? b0[j & 3] : b1[j & 3]; const float y = (v[j] - mean) * rstd * g + b;
                    VT[(d0 + j) * VP + s] = (bf16)(cvt_pk_bf16(y, y) & 0xffffu); } } }
        {   const int nu = unit + ustep; if (nu < uend) { const bf16* vp = zb + (size_t)((nu >> 4) * CHUNK + s) * 4096 + GW + (nu & 15) * 128 + q4 * 32;
#pragma unroll
                for (int c = 0; c < 4; ++c) vw[c] = *(const v4u*)(vp + 8 * c); } }
        __syncthreads();
        {   const int t0 = 16 * wave, nks = (wave >> 1) + 1;
            const int tok = tok0 + t0 + r; const float bias = bs[h * CHUNK + t0 + r];
            f32x4 acc[8];
#pragma unroll
            for (int i = 0; i < 8; ++i) acc[i] = (f32x4){0.f, 0.f, 0.f, 0.f};
            for (int ks = 0; ks < nks; ++ks) {
                const bf16x8 yf = *(const bf16x8*)(wc + ((size_t)h * CHUNK + t0 + r) * CHUNK + 32 * ks + 8 * kq);
#pragma unroll
                for (int dt = 0; dt < 8; ++dt) { const bf16x8 xf = *(const LAS bf16x8*)(VT + (dt * 16 + r) * VP + 32 * ks + 8 * kq); acc[dt] = __builtin_amdgcn_mfma_f32_16x16x32_bf16(xf, yf, acc[dt], 0, 0, 0); }
            }
#pragma unroll
            for (int dt = 0; dt < 8; ++dt) { const int col = h * 128 + dt * 16 + 4 * kq;
                v2u o; o.x = cvt_pk_bf16(bf_lo(uw[dt].x) * (acc[dt][0] + bias), bf_hi(uw[dt].x) * (acc[dt][1] + bias)); o.y = cvt_pk_bf16(bf_lo(uw[dt].y) * (acc[dt][2] + bias), bf_hi(uw[dt].y) * (acc[dt][3] + bias));
                *(v2u*)(gb + (size_t)tok * D + col) = o; }
        }
    }
    __syncthreads();
}

constexpr int SC_BP = 20, SC_SP = 136, SC_STRIDE = 16640, SC_E_OFF = 8 * SC_STRIDE;
template <bool EMIT, bool CONV> __device__ __forceinline__ void scan_segment(LAS float* BU, LAS bf16* SL, LAS bf16* YB, const bf16* up, bf16* ofl, const bf16x8 (&Bf)[8], const bf16x8 (&Cf)[4], const bf16x8 Df,
                                                                  const float lr, const float li, float& sr, float& si, const int lane, unsigned char* ws, const int gw, const int NGW, const int NBT) {
    constexpr int BP = SC_BP, SP = SC_SP;
    const int c = lane & 15, kq = lane >> 4;
    v4u un[4];
#pragma unroll
    for (int c4 = 0; c4 < 4; ++c4) un[c4] = *(const v4u*)(up + (size_t)(c4 * 16) * D);
    f32x4 cv[CONV ? 16 : 1]; int pend = -1;
    for (int bt = 0; bt <= NBT; ++bt) {
        if constexpr (CONV) {
            if (pend >= 0) { const TrD d = l1_desc(pend, ws); tr_finish(d.K, d.nblk, d.ks, d.WT, d.mode, (LAS unsigned*)BU, d.item, lane, cv); pend = -1; }
            const int it = gw + bt * NGW;
            if (bt < NBT && it < L1_NIT) { const TrD d = l1_desc(it, ws); tr_issue(d.W, d.ldn, d.nblk, d.item, lane, cv); pend = it; }
#if CONV_IMMEDIATE
            if (pend >= 0) { const TrD d = l1_desc(pend, ws); tr_finish(d.K, d.nblk, d.ks, d.WT, d.mode, (LAS unsigned*)BU, d.item, lane, cv); pend = -1; }
#endif
        }
        v4u uc[4];
#pragma unroll
        for (int c4 = 0; c4 < 4; ++c4) uc[c4] = un[c4];
        if (EMIT && bt > 0) { const v4u y0 = *(const LAS v4u*)(YB + lane * 8), y1 = *(const LAS v4u*)(YB + 512 + lane * 8); bf16* o = ofl + (size_t)(bt - 1) * 64 * D; *(v4u*)o = y0; *(v4u*)(o + (size_t)32 * D) = y1; }
        if (bt == NBT) break;
        if (bt + 1 < NBT) {
#pragma unroll
            for (int c4 = 0; c4 < 4; ++c4) un[c4] = *(const v4u*)(up + (size_t)(((bt + 1) * 4 + c4) * 16) * D); }
#pragma unroll
        for (int c4 = 0; c4 < 4; ++c4) {
            v4u uw = uc[c4]; if (kq >= 2) uw = (v4u){0u, 0u, 0u, 0u};
            const bf16x8 Uf = __builtin_bit_cast(bf16x8, uw);
#pragma unroll
            for (int j = 0; j < 8; ++j) { const f32x4 d4 = __builtin_amdgcn_mfma_f32_16x16x32_bf16(Uf, Bf[j], (f32x4){0.f, 0.f, 0.f, 0.f}, 0, 0, 0); *(LAS f32x4*)(BU + (16 * j + c) * BP + 4 * kq) = d4; }
            LDS_WAIT();
            f32x4 bre[4], bim[4];
#pragma unroll
            for (int q = 0; q < 4; ++q) { bre[q] = *(const LAS f32x4*)(BU + lane * BP + 4 * q); bim[q] = *(const LAS f32x4*)(BU + (64 + lane) * BP + 4 * q); }
#pragma unroll
            for (int t = 0; t < 16; ++t) { const float nr = lr * sr - li * si + bre[t >> 2][t & 3], ni = lr * si + li * sr + bim[t >> 2][t & 3]; sr = nr; si = ni;
                if (EMIT) *(LAS unsigned*)(SL + t * SP + 2 * lane) = cvt_pk_bf16(sr, si); }
            if (EMIT) {
                LDS_WAIT();
                f32x4 y = __builtin_amdgcn_mfma_f32_16x16x32_bf16(Uf, Df, (f32x4){0.f, 0.f, 0.f, 0.f}, 0, 0, 0);
#pragma unroll
                for (int ks = 0; ks < 4; ++ks) { const bf16x8 xs = *(const LAS bf16x8*)(SL + c * SP + 32 * ks + 8 * kq); y = __builtin_amdgcn_mfma_f32_16x16x32_bf16(xs, Cf[ks], y, 0, 0, 0); }
#pragma unroll
                for (int i = 0; i < 4; ++i) { const float gy = gelu_tanh(y[i]); YB[(c4 * 16 + 4 * kq + i) * 16 + c] = (bf16)(cvt_pk_bf16(gy, gy) & 0xffffu); }
            }
            LDS_WAIT();
        }
    }
}
__device__ __forceinline__ void scan_phase(LAS unsigned char* lds, int tid_in, int lane_in, int wave) {
    int tid = tid_in; asm volatile("" : "+v"(tid)); const int lane = tid & 63; (void)lane_in;
    unsigned char* ws = WSP();
    const bf16* ub = (const bf16*)(ws + WS_H); bf16* gb = (bf16*)(ws + WS_G);
    LAS float* BU = (LAS float*)(lds + wave * SC_STRIDE); LAS bf16* SL = (LAS bf16*)(lds + wave * SC_STRIDE + 128 * SC_BP * 4); LAS bf16* YB = (LAS bf16*)(lds + wave * SC_STRIDE + 128 * SC_BP * 4 + 16 * SC_SP * 2);
    const int c = lane & 15, kq = lane >> 4, seq = wave >> 2, seg = wave & 3;
    LAS float* EB = (LAS float*)(lds + SC_E_OFF) + seq * 4 * 128;
    for (int task = blockIdx.x * 2 + seq; task < NB * S5G; task += gridDim.x * 2) {
        const int b = task >> 7, g = task & 127;
        const float dt = __expf(INP(I_LOGDT)[g]);
        float lr, li;
        {   const float are = INP(I_ARE)[g * S5P + lane], aim = INP(I_AIM)[g * S5P + lane]; const float mag = expf(are * dt); float sn, cs; sincosf(aim * dt, &sn, &cs); lr = mag * cs; li = mag * sn; }
        bf16x8 Bf[8], Cf[4], Df;
#pragma unroll
        for (int j = 0; j < 8; ++j) { const int R = 16 * j + c, pp = R & 63; const bool isim = R >= 64;
            const float are = INP(I_ARE)[g * S5P + pp], aim = INP(I_AIM)[g * S5P + pp]; const float mag = expf(are * dt); float sn, cs; sincosf(aim * dt, &sn, &cs);
            const float nr = mag * cs - 1.0f, ni = mag * sn, inv = 1.0f / (are * are + aim * aim);
            const float cr = (nr * are + ni * aim) * inv, ci = (ni * are - nr * aim) * inv;
            float v[8];
            if (kq < 2) { const float* pbr = INP(I_BRE) + (size_t)(g * S5P + pp) * S5C + 8 * kq; const float* pbi = INP(I_BIM) + (size_t)(g * S5P + pp) * S5C + 8 * kq;
                const f32x4 br0 = *(const f32x4*)pbr, br1 = *(const f32x4*)(pbr + 4), bi0 = *(const f32x4*)pbi, bi1 = *(const f32x4*)(pbi + 4);
#pragma unroll
                for (int e = 0; e < 8; ++e) { const float bre = e < 4 ? br0[e & 3] : br1[e & 3], bim = e < 4 ? bi0[e & 3] : bi1[e & 3]; v[e] = isim ? (cr * bim + ci * bre) : (cr * bre - ci * bim); }
            } else {
#pragma unroll
                for (int e = 0; e < 8; ++e) v[e] = 0.f; }
            v4u w; w.x = cvt_pk_bf16(v[0], v[1]); w.y = cvt_pk_bf16(v[2], v[3]); w.z = cvt_pk_bf16(v[4], v[5]); w.w = cvt_pk_bf16(v[6], v[7]); Bf[j] = __builtin_bit_cast(bf16x8, w); }
#pragma unroll
        for (int ks = 0; ks < 4; ++ks) { const size_t o = (size_t)(g * S5C + c) * S5P + 16 * ks + 4 * kq; const f32x4 cr4 = *(const f32x4*)(INP(I_CRE) + o), ci4 = *(const f32x4*)(INP(I_CIM) + o);
            v4u w; w.x = cvt_pk_bf16(cr4[0], -ci4[0]); w.y = cvt_pk_bf16(cr4[1], -ci4[1]); w.z = cvt_pk_bf16(cr4[2], -ci4[2]); w.w = cvt_pk_bf16(cr4[3], -ci4[3]); Cf[ks] = __builtin_bit_cast(bf16x8, w); }
        {   const float dv = INP(I_S5D)[g * S5C + c]; float v[8];
#pragma unroll
            for (int e = 0; e < 8; ++e) v[e] = (kq < 2 && (8 * kq + e) == c) ? dv : 0.f;
            v4u w; w.x = cvt_pk_bf16(v[0], v[1]); w.y = cvt_pk_bf16(v[2], v[3]); w.z = cvt_pk_bf16(v[4], v[5]); w.w = cvt_pk_bf16(v[6], v[7]); Df = __builtin_bit_cast(bf16x8, w); }
        const int nbt = (seg < 3) ? SEG_B : (SEQ / 64 - 3 * SEG_B); const int t0 = seg * (SEG_B * 64);
        const bf16* up = ub + (size_t)(b * SEQ + t0 + c) * D + g * S5C + 8 * (kq & 1);
        bf16* ofl = gb + (size_t)(b * SEQ + t0 + (lane >> 1)) * D + g * S5C + (lane & 1) * 8;
        float sr = 0.f, si = 0.f;
        const int gw = blockIdx.x * 8 + wave, NGW = gridDim.x * 8;
#if CONV_PLAIN
        constexpr int KA = CONV_KA;
        for (int k = 0; k < KA; ++k) { const int it = gw + k * NGW; if (it < L1_NIT) { const TrD d = l1_desc(it, ws); tr_item(d.W, d.K, d.ldn, d.nblk, d.ks, d.WT, d.mode, (LAS unsigned*)BU, d.item, lane); } }
        if (seg < 3) scan_segment<false, false>(BU, SL, YB, up, ofl, Bf, Cf, Df, lr, li, sr, si, lane, ws, gw, NGW, nbt);
        else { for (int it = KA * NGW + (int)blockIdx.x * 2 + seq; it < L1_NIT; it += (int)gridDim.x * 2) { const TrD d = l1_desc(it, ws); tr_item(d.W, d.K, d.ldn, d.nblk, d.ks, d.WT, d.mode, (LAS unsigned*)BU, d.item, lane); } }
        if (false)
#endif
        if (seg < 3) scan_segment<false, CONV_IN_SCAN != 0>(BU, SL, YB, up, ofl, Bf, Cf, Df, lr, li, sr, si, lane, ws, gw, NGW, nbt);
        else if (CONV_IN_SCAN) { for (int bt = 0; bt < 8; ++bt) { const int it = gw + bt * NGW; if (it < L1_NIT) { const TrD d = l1_desc(it, ws); tr_item(d.W, d.K, d.ldn, d.nblk, d.ks, d.WT, d.mode, (LAS unsigned*)BU, d.item, lane); } } }
        EB[(seg * 64 + lane) * 2] = sr; EB[(seg * 64 + lane) * 2 + 1] = si;
        __syncthreads();
        float Lr = 1.f, Li = 0.f;
        {   float pr = lr, pi = li;
#pragma unroll
            for (int q = 0; q < 11; ++q) { if (((SEG_B * 64) >> q) & 1) { const float nr = Lr * pr - Li * pi, ni = Lr * pi + Li * pr; Lr = nr; Li = ni; }
                const float sr2 = pr * pr - pi * pi, si2 = 2.0f * pr * pi; pr = sr2; pi = si2; } }
        sr = 0.f; si = 0.f;
        for (int j = 0; j < seg; ++j) { const float er = EB[(j * 64 + lane) * 2], ei = EB[(j * 64 + lane) * 2 + 1]; const float nr = Lr * sr - Li * si + er, ni = Lr * si + Li * sr + ei; sr = nr; si = ni; }
        scan_segment<true, false>(BU, SL, YB, up, ofl, Bf, Cf, Df, lr, li, sr, si, lane, ws, gw, NGW, nbt);
        __syncthreads();
    }
}

__device__ __forceinline__ void final_norm(int lane_in, int wave) {
    int lane = lane_in; asm volatile("" : "+v"(lane));
    const int gw = blockIdx.x * 8 + wave, NGW = gridDim.x * 8; const f32x4* g4 = (const f32x4*)INP(I_NFIN) + lane;
    for (int m = gw; m < M; m += NGW) {
        f32x4* xr = (f32x4*)(OUTP() + (size_t)m * D) + lane; f32x4 v[8]; float s = 0.f;
#pragma unroll
        for (int j = 0; j < 8; ++j) { v[j] = xr[64 * j]; s += (v[j][0] * v[j][0] + v[j][1] * v[j][1]) + (v[j][2] * v[j][2] + v[j][3] * v[j][3]); }
        const float rs = rsqrtf(wave_sum(s) * (1.0f / D) + EPS);
#pragma unroll
        for (int j = 0; j < 8; ++j) xr[64 * j] = v[j] * rs * g4[64 * j];
    }
}

#define RLX_AGENT __ATOMIC_RELAXED, __HIP_MEMORY_SCOPE_AGENT
#define XB_TMO      128
#define XB_XCNT(j)  (256  + 64 * (j))
#define XB_XSUB(j)  (1280 + 64 * (j))
#define XB_XGEN(j)  (2304 + 64 * (j))
#define XB_TOP      3328
#define XB_TOPGEN   3392
#define XCD_BAR_WORDS 3456
#define XB_SPIN_CAP (1u << 18)

__device__ __forceinline__ unsigned xb_ld(unsigned* p)              { return __hip_atomic_load(p, __ATOMIC_RELAXED, __HIP_MEMORY_SCOPE_AGENT); }
__device__ __forceinline__ unsigned xb_add(unsigned* p, unsigned v) { return __hip_atomic_fetch_add(p, v, __ATOMIC_RELAXED, __HIP_MEMORY_SCOPE_AGENT); }
__device__ __forceinline__ unsigned xb_xcc_id() { return (unsigned)__builtin_amdgcn_s_getreg((3 << 11) | 20) & 0xFu; }
#define XB_SPIN(cond, bar) do { unsigned _sp = 0; while (cond) { __builtin_amdgcn_s_sleep(XB_SLEEP); \
    if ((++_sp & 255u) == 0u) { if (xb_ld(&(bar)[XB_TMO])) break; if (_sp > XB_SPIN_CAP) { atomicAdd(&(bar)[XB_TMO], 1u); break; } } } } while (0)

struct XcdBarrier {
    unsigned* bar; unsigned x;
    volatile LAS unsigned* st;
};

__device__ __forceinline__ XcdBarrier xcd_barrier_post(unsigned* bar, volatile LAS unsigned* st) {
    XcdBarrier b; b.bar = bar; b.x = xb_xcc_id(); b.st = st;
    if (threadIdx.x == 0) (void)xb_add(&bar[XB_XCNT(b.x)], 1u);
    return b;
}
__device__ __forceinline__ void xcd_barrier_complete(unsigned* bar, unsigned x, unsigned& nloc, unsigned& nx) {
    const unsigned G = gridDim.x * gridDim.y * gridDim.z;
    unsigned sum, cnt, mine, sp = 0u;
    for (;;) {
        sum = 0u; cnt = 0u; mine = 0u;
#pragma unroll
        for (unsigned j = 0; j < 16; ++j) { const unsigned c = xb_ld(&bar[XB_XCNT(j)]); sum += c; cnt += (c > 0u) ? 1u : 0u; mine = (j == x) ? c : mine; }
        if (sum == G) break;
        __builtin_amdgcn_s_sleep(1);
        if ((++sp & 255u) == 0u) { if (xb_ld(&bar[XB_TMO])) break; if (sp > XB_SPIN_CAP) { atomicAdd(&bar[XB_TMO], 1u); break; } }
    }
    nloc = mine > 0u ? mine : 1u; nx = cnt > 0u ? cnt : 1u;
}

__device__ __forceinline__ void xcd_barrier(const XcdBarrier& b) {
    asm volatile("s_waitcnt vmcnt(0)" ::: "memory");
    __syncthreads();
    if (threadIdx.x == 0) {
        unsigned* bar = b.bar;
        __builtin_amdgcn_s_waitcnt(0);
        unsigned nloc = b.st[0], nx = b.st[1];
        if (nloc == 0u) { xcd_barrier_complete(bar, b.x, nloc, nx); b.st[0] = nloc; b.st[1] = nx; }
        const unsigned old = xb_add(&bar[XB_XSUB(b.x)], 1u);
        const unsigned gen = old / nloc;
        if (old + 1u == (gen + 1u) * nloc) {
            __builtin_amdgcn_fence(__ATOMIC_RELEASE, "agent");
            asm volatile("s_waitcnt vmcnt(0)" ::: "memory");
            const unsigned og = xb_add(&bar[XB_TOP], 1u);
            const unsigned tg = og / nx;
            if (og + 1u == (tg + 1u) * nx) xb_add(&bar[XB_TOPGEN], 1u);
            else XB_SPIN(xb_ld(&bar[XB_TOPGEN]) == tg, bar);
            __builtin_amdgcn_fence(__ATOMIC_ACQUIRE, "agent");
            xb_add(&bar[XB_XGEN(b.x)], 1u);
            asm volatile("s_waitcnt vmcnt(0)" ::: "memory");
        } else {
            XB_SPIN(xb_ld(&bar[XB_XGEN(b.x)]) == gen, bar);
            __builtin_amdgcn_fence(__ATOMIC_ACQUIRE, "agent");
            asm volatile("s_waitcnt vmcnt(0)" ::: "memory");
        }
    }
    __syncthreads();
}

__device__ __forceinline__ void prefetch_b0(LAS unsigned char* lds, const pg8::bf16_t* Bt, int K, int N, int wave) {
#if PFB_ON
    pg8::StaticOrder S; S.init(M, N, (int)gridDim.x, (int)blockIdx.x); pg8::Unit u; if (!S.next(0, u)) return;
    const int tid = wave * 64 + pg8::lane_id_now();
    const char* base = (const char*)Bt + ((size_t)u.pn * 256 + (tid & 255)) * K * 2 + (tid >> 8) * 256;
    __builtin_amdgcn_global_load_lds((const unsigned*)base, (LAS unsigned*)(lds + 131072 + wave * 256), 4, 0, 0);
    __builtin_amdgcn_global_load_lds((const unsigned*)(base + 128), (LAS unsigned*)(lds + 131072 + wave * 256), 4, 0, 0);
#endif
}
struct EpiFinal {
    static constexpr bool PERM = true, AFTER_DRAIN = true;
    const pg8::bf16_t* xin_b; float* out; float* part_out; const float* part_in; const pg8::bf16_t* proj; const float* gfin; XcdBarrier bar;
    __device__ __forceinline__ void fused(pg8::f32x4 (&acc)[2][2][4][2], const pg8::Unit& u, int wr, int wc, int fr, int fq, LAS unsigned char*, int, int) const {
        using namespace pg8;
        const int row0 = u.pm * BM + wr * 64 + fr, col0 = u.pn * BM + wc * 32 + 8 * fq;
#pragma unroll
        for (int ai = 0; ai < 2; ++ai)
#pragma unroll
            for (int m = 0; m < 4; ++m) { const int row = row0 + ai * HALF + m * 16;
                const float rs = row_rstd<32>(part_in, row, fq);
                const size_t off = (size_t)row * DM + col0; float ss = 0.f;
#pragma unroll
                for (int bj = 0; bj < 2; ++bj) { const size_t o = off + bj * HALF;
                    const u32x4 xw = *(const u32x4*)(xin_b + o); const u32x4 pw = *(const u32x4*)(proj + o); const pg8::f32x4 a0 = acc[ai][bj][m][0], a1 = acc[ai][bj][m][1]; pg8::f32x4 n0, n1;
                    n0[0] = bf_lo(xw.x) + fast_sigmoid(a0[0] * rs) * bf_lo(pw.x); n0[1] = bf_hi(xw.x) + fast_sigmoid(a0[1] * rs) * bf_hi(pw.x);
                    n0[2] = bf_lo(xw.y) + fast_sigmoid(a0[2] * rs) * bf_lo(pw.y); n0[3] = bf_hi(xw.y) + fast_sigmoid(a0[3] * rs) * bf_hi(pw.y);
                    n1[0] = bf_lo(xw.z) + fast_sigmoid(a1[0] * rs) * bf_lo(pw.z); n1[1] = bf_hi(xw.z) + fast_sigmoid(a1[1] * rs) * bf_hi(pw.z);
                    n1[2] = bf_lo(xw.w) + fast_sigmoid(a1[2] * rs) * bf_lo(pw.w); n1[3] = bf_hi(xw.w) + fast_sigmoid(a1[3] * rs) * bf_hi(pw.w);
                    acc[ai][bj][m][0] = n0; acc[ai][bj][m][1] = n1;
                    ss += ((n0[0] * n0[0] + n0[1] * n0[1]) + (n0[2] * n0[2] + n0[3] * n0[3])) + ((n1[0] * n1[0] + n1[1] * n1[1]) + (n1[2] * n1[2] + n1[3] * n1[3])); }
                ss += __shfl_xor(ss, 16); ss += __shfl_xor(ss, 32);
                if (fq == 0) part_out[(size_t)row * 32 + u.pn * 4 + wc] = ss;
                asm volatile("" ::: "memory"); }
        xcd_barrier(bar);
#pragma unroll
        for (int ai = 0; ai < 2; ++ai)
#pragma unroll
            for (int m = 0; m < 4; ++m) { const int row = row0 + ai * HALF + m * 16;
                const float rs = row_rstd<32>(part_out, row, fq);
                const size_t off = (size_t)row * DM + col0;
#pragma unroll
                for (int bj = 0; bj < 2; ++bj) { const int cc = col0 + bj * HALF; const pg8::f32x4 g0 = *(const pg8::f32x4*)(gfin + cc), g1 = *(const pg8::f32x4*)(gfin + cc + 4);
                    *(pg8::f32x4*)(out + off + bj * HALF) = acc[ai][bj][m][0] * rs * g0; *(pg8::f32x4*)(out + off + bj * HALF + 4) = acc[ai][bj][m][1] * rs * g1; }
                asm volatile("" ::: "memory"); }
    }
};

#define PH_BEGIN unsigned char* ws = WSP(); const int G = gridDim.x, bid = blockIdx.x; const int a = layer & 1; \
        b16* xb_a = (b16*)(ws + (a ? WS_XB1 : WS_XB0)); b16* xb_o = (b16*)(ws + (a ? WS_XB0 : WS_XB1)); \
        float* part_a = (float*)(ws + (a ? WS_PART1 : WS_PART0)); float* part_o = (float*)(ws + (a ? WS_PART0 : WS_PART1)); (void)xb_a; (void)xb_o; (void)part_a; (void)part_o; (void)G; (void)bid;
#define TID_NOW() (wave * 64 + pg8::lane_id_now())
template <int layer> __device__ __forceinline__ void run_layer(LAS unsigned char* lds, const int wave, const XcdBarrier& bar) {
    typedef pg8::bf16_t b16;
        if (PHMASK & 2) { PH_BEGIN
            pg8::Gemm g{(const b16*)(ws + WS_PB) + (size_t)layer * M * PLE, (const b16*)(ws + WS_PLEP + (size_t)layer * MiB), M, D, PLE}; pg8::StaticOrder S; S.init(M, D, G, bid);
            pg8::EpiBf16G<0, false, false, 32> E{(b16*)(ws + WS_PROJ), D, nullptr, nullptr, 0};
            pg8::gemm_phase<pg8::EpiBf16G<0, false, false, 32>, pg8::StaticOrder, ALIGN_ON, true>(lds, g, S, E, wave); }
        if (layer == 0) {
            if (PHMASK & 4) { PH_BEGIN
                pg8::Gemm g{xb_a, (const b16*)(ws + WS_GMIN), M, 4096, D}; pg8::StaticOrder S; S.init(M, 4096, G, bid);
                pg8::EpiBf16G<1, true, true, 32> E{(b16*)(ws + WS_H), 4096, part_a, (float*)(ws + WS_VSTAT), 8};
                pg8::gemm_phase<pg8::EpiBf16G<1, true, true, 32>, pg8::StaticOrder, ALIGN_ON, true>(lds, g, S, E, wave); }
            xcd_barrier(bar);
            spatial_phase(lds, TID_NOW(), 0, wave);
            if (REP_SPAT > 1) spatial_phase(lds, TID_NOW(), 0, wave);
            if (REP_SPAT > 2) spatial_phase(lds, TID_NOW(), 0, wave);
            prefetch_b0(lds, (const pg8::bf16_t*)(WSP() + WS_GMOUT), D, D, wave);
            xcd_barrier(bar);
            if (PHMASK & 16) { PH_BEGIN
                pg8::Gemm g{(const b16*)(ws + WS_G), (const b16*)(ws + WS_GMOUT), M, D, D}; pg8::StaticOrder S; S.init(M, D, G, bid);
#if P3_BF16_RES
                pg8::EpiRes<0, 32, false, false> E{nullptr, xb_a, nullptr, xb_o, part_o, nullptr, nullptr};
                pg8::gemm_phase<pg8::EpiRes<0, 32, false, false>, pg8::StaticOrder, ALIGN_ON, true>(lds, g, S, E, wave); }
#else
                pg8::EpiRes<0, 32, true, false> E{INP(I_X), nullptr, nullptr, xb_o, part_o, nullptr, nullptr};
                pg8::gemm_phase<pg8::EpiRes<0, 32, true, false>, pg8::StaticOrder, ALIGN_ON, true>(lds, g, S, E, wave); }
#endif
            prefetch_b0(lds, (const pg8::bf16_t*)(WSP() + WS_FFN13), D, 2 * FF, wave);
            xcd_barrier(bar);
        } else {
            if (PHMASK & 32) { PH_BEGIN
                pg8::Gemm g{xb_a, (const b16*)(ws + WS_S5IN), M, D, D}; pg8::StaticOrder S; S.init(M, D, G, bid);
                pg8::EpiBf16G<0, true, false, 32> E{(b16*)(ws + WS_H), D, part_a, nullptr, 0};
                pg8::gemm_phase<pg8::EpiBf16G<0, true, false, 32>, pg8::StaticOrder, ALIGN_ON, true>(lds, g, S, E, wave); }
            xcd_barrier(bar);
            scan_phase(lds, TID_NOW(), 0, wave);
            if (REP_SCAN > 1) scan_phase(lds, TID_NOW(), 0, wave);
            if (REP_SCAN > 2) scan_phase(lds, TID_NOW(), 0, wave);
#ifdef DBL_BAR
            xcd_barrier(bar);
#endif
            prefetch_b0(lds, (const pg8::bf16_t*)(WSP() + WS_S5OUT), D, 4096, wave);
            xcd_barrier(bar);
            if (PHMASK & 128) { PH_BEGIN
                pg8::Gemm g{(const b16*)(ws + WS_G), (const b16*)(ws + WS_S5OUT), M, 4096, D}; pg8::StaticOrder S; S.init(M, 4096, G, bid);
                pg8::EpiGLURes E{xb_a, xb_o, part_o};
                pg8::gemm_phase<pg8::EpiGLURes, pg8::StaticOrder, ALIGN_ON, true>(lds, g, S, E, wave); }
            prefetch_b0(lds, (const pg8::bf16_t*)(WSP() + WS_FFN13 + (size_t)layer * 44 * MiB), D, 2 * FF, wave);
            xcd_barrier(bar);
        }
        for (int rep = 0; rep < REP_UP; ++rep) { PH_BEGIN
            pg8::Gemm g{xb_o, (const b16*)(ws + WS_FFN13 + (size_t)layer * 44 * MiB), M, 2 * FF, D}; pg8::HalfTailOrder S; S.init(M, 2 * FF, G, bid); S.full_rounds = HALFM_ON ? (M / 256) * (2 * FF / 256) / G : 1000;
            if (layer == 0) { pg8::EpiSwiGLU<32> E{(b16*)(ws + WS_H), FF, part_o}; pg8::gemm_phase<pg8::EpiSwiGLU<32>, pg8::HalfTailOrder, ALIGN_ON, true, HALFM_ON>(lds, g, S, E, wave); }
            else { pg8::EpiSwiGLU<64> E{(b16*)(ws + WS_H), FF, part_o}; pg8::gemm_phase<pg8::EpiSwiGLU<64>, pg8::HalfTailOrder, ALIGN_ON, true, HALFM_ON>(lds, g, S, E, wave); } }
        prefetch_b0(lds, (const pg8::bf16_t*)(WSP() + WS_FFN2 + (size_t)layer * 22 * MiB), FF, D, wave);
        xcd_barrier(bar);
        if (PHMASK & 512) { PH_BEGIN
            pg8::Gemm g{(const b16*)(ws + WS_H), (const b16*)(ws + WS_FFN2 + (size_t)layer * 22 * MiB), M, D, FF}; pg8::StaticOrder S; S.init(M, D, G, bid);
            pg8::EpiRes<0, 32, false, false> E{nullptr, xb_o, nullptr, xb_a, part_a, nullptr, nullptr};
            pg8::gemm_phase<pg8::EpiRes<0, 32, false, false>, pg8::StaticOrder, ALIGN_ON, true>(lds, g, S, E, wave); }
        prefetch_b0(lds, (const pg8::bf16_t*)(WSP() + WS_PLEG + (size_t)layer * 8 * MiB), D, D, wave);
        xcd_barrier(bar);
        if (PHMASK & 1024) { PH_BEGIN
            pg8::Gemm g{xb_a, (const b16*)(ws + WS_PLEG + (size_t)layer * 8 * MiB), M, D, D}; pg8::StaticOrder S; S.init(M, D, G, bid);
            if (layer == 0) { pg8::EpiRes<1, 32, false, false> E{nullptr, xb_a, nullptr, xb_o, part_o, part_a, (const b16*)(ws + WS_PROJ)};
                pg8::gemm_phase<pg8::EpiRes<1, 32, false, false>, pg8::StaticOrder, ALIGN_ON, true>(lds, g, S, E, wave); }
            else { EpiFinal E{xb_a, OUTP(), part_o, part_a, (const b16*)(ws + WS_PROJ), INP(I_NFIN), bar};
                pg8::gemm_phase<EpiFinal, pg8::StaticOrder, false, true>(lds, g, S, E, wave); } }
        if (layer == 0) prefetch_b0(lds, (const pg8::bf16_t*)(WSP() + WS_PLEP + 1 * MiB), PLE, D, wave);
        if (layer == 0) xcd_barrier(bar);
    }

__global__ void __launch_bounds__(512, 2) mk_fwd(Params P) {
    extern __shared__ __attribute__((aligned(16))) unsigned char lds_raw[];
    LAS unsigned char* lds = (LAS unsigned char*)lds_raw;
    cg::grid_group grid = cg::this_grid();
    const int wave = __builtin_amdgcn_readfirstlane(threadIdx.x >> 6);
    typedef pg8::bf16_t b16;
    volatile LAS unsigned* MISC = (volatile LAS unsigned*)(lds + MISC_OFF);
    if (threadIdx.x < 64) MISC[threadIdx.x] = 0u;
    __syncthreads();
    const XcdBarrier bar = xcd_barrier_post((unsigned*)(WSP() + WS_CTL), MISC + 8);

    prologue(lds, TID_NOW(), 0, wave);
    if (REP_PRO > 1) prologue(lds, TID_NOW(), 0, wave);
    if (REP_PRO > 2) prologue(lds, TID_NOW(), 0, wave);
    if (WSP() == nullptr) grid.sync();
    xcd_barrier(bar);
    for (int rep = 0; rep < EXTRA_SYNC; ++rep) xcd_barrier(bar);

    run_layer<0>(lds, wave, bar);
    run_layer<1>(lds, wave, bar);
}

extern "C" void kernel_launch(void* const* d_in, const int* in_sizes, int n_in, void* d_out, int out_size, void* d_ws, size_t ws_size, hipStream_t stream) {
    static int grid = 0;
    if (grid == 0) {
        if (n_in != 27 || in_sizes[0] != M * D || out_size != M * D || ws_size < WS_END) { fprintf(stderr, "kernel_launch: unexpected shapes: n_in %d in0 %d out %d ws %zu (need %zu)\n", n_in, n_in > 0 ? in_sizes[0] : -1, out_size, ws_size, (size_t)WS_END); grid = -1; return; }
        int dev = 0, cus = 0, per_cu = 0;
        if (hipGetDevice(&dev) != hipSuccess || hipDeviceGetAttribute(&cus, hipDeviceAttributeMultiprocessorCount, dev) != hipSuccess) { grid = -1; return; }
        if (hipFuncSetAttribute((const void*)mk_fwd, hipFuncAttributeMaxDynamicSharedMemorySize, LDS_BYTES) != hipSuccess) { fprintf(stderr, "kernel_launch: hipFuncSetAttribute failed\n"); grid = -1; return; }
        if (hipOccupancyMaxActiveBlocksPerMultiprocessor(&per_cu, (const void*)mk_fwd, 512, LDS_BYTES) != hipSuccess || per_cu < 1) { fprintf(stderr, "kernel_launch: occupancy query reports %d workgroups per CU\n", per_cu); (void)hipGetLastError(); grid = -1; return; }
        grid = cus;
    }
    if (grid < 0) return;
    if (hipMemsetAsync((char*)d_ws + WS_CTL, 0, CTL_ZERO_BYTES, stream) != hipSuccess) { fprintf(stderr, "kernel_launch: hipMemsetAsync failed\n"); return; }
    Params p{};
    for (int i = 0; i < 27; ++i) p.in[i] = (const float*)d_in[i];
    p.out = (float*)d_out; p.ws = (unsigned char*)d_ws;
    void* args[] = {&p};
    const hipError_t e = hipLaunchCooperativeKernel((const void*)mk_fwd, dim3(grid), dim3(512), args, LDS_BYTES, stream);
    if (e != hipSuccess) fprintf(stderr, "kernel_launch: cooperative launch failed: %s (grid %d)\n", hipGetErrorString(e), grid);
}
```
